# Optimizing an MI355X kernel written in HIP

```python
import jax, jax.numpy as jnp
from jax import lax
import numpy as np

D_MODEL = 1024
BATCH = 8
SEQ = 4096
DEPTH = 1
DEC_BATCH = 128
DEC_SEQ = 1
PAST_LEN = 16384
PAGE_SIZE = 128

MIX_WIDTH = D_MODEL
HEAD_DIM = 64
ATTN_WIDTH = MIX_WIDTH // 2
N_Q_HEADS = ATTN_WIDTH // HEAD_DIM
N_KV_HEADS = 2
GQA_GROUP = N_Q_HEADS // N_KV_HEADS
KV_WIDTH = N_KV_HEADS * HEAD_DIM
WINDOW = 128
GM_WIDTH = MIX_WIDTH - ATTN_WIDTH
GM_GROUPS = 4
GM_DIM = GM_WIDTH // GM_GROUPS
CHUNK = 128
D_FF = 2816
PLE_DIM = 256
IN_COLS = ATTN_WIDTH + 2 * KV_WIDTH + 2 * GM_WIDTH
SPLITS = (ATTN_WIDTH, ATTN_WIDTH + KV_WIDTH, ATTN_WIDTH + 2 * KV_WIDTH,
          ATTN_WIDTH + 2 * KV_WIDTH + GM_WIDTH)
RMS_EPS = 1e-6
LN_EPS = 1e-5
ATTN_SCALE = HEAD_DIM ** -0.5

kernel_name = "hymba_swa_sink_gmlp_macaron_step"


def rms_norm(x, g):
    xf = x.astype(jnp.float32)
    y = xf * lax.rsqrt(jnp.mean(xf * xf, axis=-1, keepdims=True) + RMS_EPS)
    return (y * g.astype(jnp.float32)).astype(x.dtype)


def layer_norm(x, g, b):
    xf = x.astype(jnp.float32)
    mu = jnp.mean(xf, axis=-1, keepdims=True)
    xc = xf - mu
    y = xc * lax.rsqrt(jnp.mean(xc * xc, axis=-1, keepdims=True) + LN_EPS)
    return (y * g.astype(jnp.float32) + b.astype(jnp.float32)).astype(x.dtype)


def swiglu(x, w1, w3, w2):
    return (jax.nn.silu(x @ w1) * (x @ w3)) @ w2


def sink_softmax(scores, mask, sinks):
    s = jnp.where(mask, scores, -jnp.inf)
    sink = sinks.astype(jnp.float32).reshape(N_KV_HEADS, GQA_GROUP, 1, 1)
    m = jnp.maximum(jnp.max(s, axis=-1, keepdims=True), sink)
    e = jnp.exp(s - m)
    return e / (jnp.sum(e, axis=-1, keepdims=True) + jnp.exp(sink - m))


def window_attn_prompt(q, k, v, sinks):
    B, S = q.shape[:2]
    nb = -(-S // WINDOW)
    pad = nb * WINDOW - S
    qb = jnp.pad(q, ((0, 0), (0, pad), (0, 0), (0, 0), (0, 0))).reshape(
        B, nb, WINDOW, N_KV_HEADS, GQA_GROUP, HEAD_DIM)
    kp = jnp.pad(k, ((0, 0), (WINDOW, pad), (0, 0), (0, 0))).reshape(B, nb + 1, WINDOW, N_KV_HEADS, HEAD_DIM)
    vp = jnp.pad(v, ((0, 0), (WINDOW, pad), (0, 0), (0, 0))).reshape(B, nb + 1, WINDOW, N_KV_HEADS, HEAD_DIM)
    kb = jnp.concatenate([kp[:, :-1], kp[:, 1:]], axis=2)
    vb = jnp.concatenate([vp[:, :-1], vp[:, 1:]], axis=2)
    scores = jnp.einsum('bnqhgd,bnshd->bnhgqs', qb, kb,
                        preferred_element_type=jnp.float32) * ATTN_SCALE
    qi = jnp.arange(WINDOW)[:, None]
    kj = jnp.arange(2 * WINDOW)[None, :]
    rel = kj - WINDOW - qi
    band = (rel <= 0) & (rel >= -WINDOW)
    kpos = (jnp.arange(nb)[:, None] - 1) * WINDOW + jnp.arange(2 * WINDOW)[None, :]
    mask = band[None] & (kpos >= 0)[:, None, :]
    probs = sink_softmax(scores, mask[None, :, None, None], sinks)
    out = jnp.einsum('bnhgqs,bnshd->bnqhgd', probs.astype(v.dtype), vb)
    return out.reshape(B, nb * WINDOW, ATTN_WIDTH)[:, :S]


def window_attn_sample(q, k_new, v_new, k_buf, v_buf, sinks):
    Bd, T = q.shape[:2]
    k_all = jnp.concatenate([k_buf, k_new], axis=1)
    v_all = jnp.concatenate([v_buf, v_new], axis=1)
    scores = jnp.einsum('bqhgd,bshd->bhgqs', q, k_all,
                        preferred_element_type=jnp.float32) * ATTN_SCALE
    j = jnp.arange(T)[:, None]
    c = jnp.arange(WINDOW + T)[None, :]
    rel = c - WINDOW - j
    mask = (rel <= 0) & (rel >= -WINDOW)
    probs = sink_softmax(scores, mask, sinks)
    out = jnp.einsum('bhgqs,bshd->bqhgd', probs.astype(v_all.dtype), v_all)
    return out.reshape(Bd, T, ATTN_WIDTH), k_all[:, T:], v_all[:, T:]


def chunk_spatial_mix(v, w_s, b_s):
    B, S = v.shape[:2]
    nc = -(-S // CHUNK)
    pad = nc * CHUNK - S
    vc = jnp.pad(v, ((0, 0), (0, pad), (0, 0), (0, 0))).reshape(B, nc, CHUNK, GM_GROUPS, GM_DIM)
    w = w_s * jnp.tril(jnp.ones((CHUNK, CHUNK), w_s.dtype))
    out = jnp.einsum('gts,bnsgc->bntgc', w, vc) + jnp.transpose(b_s)[:, :, None]
    return out.reshape(B, nc * CHUNK, GM_GROUPS, GM_DIM)[:, :S]


def decoder_layer(x, ple, attend, g_ffn1, w1_ffn1, w3_ffn1, w2_ffn1, g_mix, w_in, b_in,
                  gm_ln_g, gm_ln_b, gm_w_s, gm_b_s, w_out, b_out,
                  g_ffn2, w1_ffn2, w3_ffn2, w2_ffn2, g_ple, w_ple_gate, w_ple_proj):
    B, S = x.shape[:2]
    x = x + 0.5 * swiglu(rms_norm(x, g_ffn1), w1_ffn1, w3_ffn1, w2_ffn1)
    z = rms_norm(x, g_mix) @ w_in + b_in
    q, k, v, u, vg = jnp.split(z, SPLITS, axis=-1)
    q = q.reshape(B, S, N_KV_HEADS, GQA_GROUP, HEAD_DIM)
    k = k.reshape(B, S, N_KV_HEADS, HEAD_DIM)
    v = v.reshape(B, S, N_KV_HEADS, HEAD_DIM)
    attn_out, k_state, v_state = attend(q, k, v)
    vg = layer_norm(jax.nn.gelu(vg), gm_ln_g, gm_ln_b)
    gm_out = jax.nn.gelu(u) * chunk_spatial_mix(
        vg.reshape(B, S, GM_GROUPS, GM_DIM), gm_w_s, gm_b_s).reshape(B, S, GM_WIDTH)
    x = x + jnp.concatenate([attn_out, gm_out], axis=-1) @ w_out + b_out
    x = x + 0.5 * swiglu(rms_norm(x, g_ffn2), w1_ffn2, w3_ffn2, w2_ffn2)
    gate = jax.nn.sigmoid(rms_norm(x, g_ple) @ w_ple_gate)
    x = x + gate * (ple @ w_ple_proj)
    return x, k_state, v_state, vg


def setup_inputs(seed: int = 0) -> dict:
    key = jax.random.key(seed)
    ks = iter(jax.random.split(key, 40))
    f32 = jnp.float32
    L, D, F = DEPTH, D_MODEL, D_FF

    def nrm(shape, scale):
        return jax.random.normal(next(ks), shape, f32) * scale

    def gain(shape):
        return 1.0 + nrm(shape, 0.05)

    return {
        "x_prompt": nrm((BATCH, SEQ, D), 1.0),
        "x_sample": nrm((DEC_BATCH, DEC_SEQ, D), 1.0),
        "cache_k_win": nrm((L, DEC_BATCH, WINDOW, N_KV_HEADS, HEAD_DIM), 1.0),
        "cache_v_win": nrm((L, DEC_BATCH, WINDOW, N_KV_HEADS, HEAD_DIM), 1.0),
        "p_prompt": nrm((L, BATCH, SEQ, PLE_DIM), 1.0),
        "p_sample": nrm((L, DEC_BATCH, DEC_SEQ, PLE_DIM), 1.0),
        "g_ffn1": gain((L, D)),
        "w1_ffn1": nrm((L, D, F), D ** -0.5),
        "w3_ffn1": nrm((L, D, F), D ** -0.5),
        "w2_ffn1": nrm((L, F, D), F ** -0.5),
        "g_mix": gain((L, D)),
        "w_in": nrm((L, D, IN_COLS), D ** -0.5),
        "b_in": nrm((L, IN_COLS), 0.02),
        "attn_sinks": nrm((L, N_Q_HEADS), 0.5),
        "gm_ln_g": gain((L, GM_WIDTH)),
        "gm_ln_b": nrm((L, GM_WIDTH), 0.02),
        "gm_w_s": nrm((L, GM_GROUPS, CHUNK, CHUNK), CHUNK ** -0.5),
        "gm_b_s": 1.0 + nrm((L, GM_GROUPS, CHUNK), 0.1),
        "w_out": nrm((L, MIX_WIDTH, D), MIX_WIDTH ** -0.5),
        "b_out": nrm((L, D), 0.02),
        "g_ffn2": gain((L, D)),
        "w1_ffn2": nrm((L, D, F), D ** -0.5),
        "w3_ffn2": nrm((L, D, F), D ** -0.5),
        "w2_ffn2": nrm((L, F, D), F ** -0.5),
        "g_ple": gain((L, D)),
        "w_ple_gate": nrm((L, D, D), D ** -0.5),
        "w_ple_proj": nrm((L, PLE_DIM, D), PLE_DIM ** -0.5),
        "g_final": gain((D,)),
    }


def reference(x_prompt, x_sample, cache_k_win, cache_v_win, p_prompt, p_sample,
              g_ffn1, w1_ffn1, w3_ffn1, w2_ffn1, g_mix, w_in, b_in, attn_sinks,
              gm_ln_g, gm_ln_b, gm_w_s, gm_b_s, w_out, b_out,
              g_ffn2, w1_ffn2, w3_ffn2, w2_ffn2, g_ple, w_ple_gate, w_ple_proj, g_final):
    xp, xs = x_prompt, x_sample
    kp_list, vp_list, ks_list, vs_list, gp_list, gs_list = [], [], [], [], [], []
    last_chunk_start = ((SEQ - 1) // CHUNK) * CHUNK
    for i in range(DEPTH):
        w = (g_ffn1[i], w1_ffn1[i], w3_ffn1[i], w2_ffn1[i], g_mix[i], w_in[i], b_in[i],
             gm_ln_g[i], gm_ln_b[i], gm_w_s[i], gm_b_s[i], w_out[i], b_out[i],
             g_ffn2[i], w1_ffn2[i], w3_ffn2[i], w2_ffn2[i], g_ple[i], w_ple_gate[i], w_ple_proj[i])
        sinks = attn_sinks[i]
        kb, vb = cache_k_win[i], cache_v_win[i]

        def attend_prompt(q, k, v, sinks=sinks):
            return window_attn_prompt(q, k, v, sinks), k[:, -WINDOW:], v[:, -WINDOW:]

        def attend_sample(q, k, v, sinks=sinks, kb=kb, vb=vb):
            return window_attn_sample(q, k, v, kb, vb, sinks)

        xp, kp_new, vp_new, gvp = decoder_layer(xp, p_prompt[i], attend_prompt, *w)
        xs, ks_new, vs_new, gvs = decoder_layer(xs, p_sample[i], attend_sample, *w)
        kp_list.append(kp_new)
        vp_list.append(vp_new)
        ks_list.append(ks_new)
        vs_list.append(vs_new)
        gp_list.append(gvp[:, last_chunk_start:])
        gs_list.append(gvs)
    y_prompt = rms_norm(xp, g_final)
    y_sample = rms_norm(xs, g_final)
    k_win_prompt = jnp.stack(kp_list)
    v_win_prompt = jnp.stack(vp_list)
    k_win_sample = jnp.stack(ks_list)
    v_win_sample = jnp.stack(vs_list)
    gm_v_prompt = jnp.stack(gp_list)
    gm_v_sample = jnp.stack(gs_list)
    return (y_prompt, y_sample, k_win_prompt, v_win_prompt, k_win_sample, v_win_sample, gm_v_prompt, gm_v_sample)
```

```cpp
#include <hip/hip_runtime.h>
#include <hip/hip_cooperative_groups.h>
#include <cstdio>
#include <cstdint>
namespace cg = cooperative_groups;
namespace pg8 {
#define PG8_LAS __attribute__((address_space(3)))
typedef unsigned short bf16_t;
typedef short bf16x8 __attribute__((ext_vector_type(8)));
typedef float f32x4 __attribute__((ext_vector_type(4)));
typedef unsigned u32x4 __attribute__((ext_vector_type(4)));
constexpr int BM = 256, BK = 64, HALF = 128, HTB = HALF * BK * 2  , STAGE_BYTES = 8 * HTB, NXCD = 8, WGM = 8;

__host__ __device__ __forceinline__ int lds_byte(int r, int c) { const int st = (r >> 4) * 2 + (c >> 5), rr = r & 15, cc = c & 31, ob = rr * 64 + cc * 2; return st * 1024 + (ob ^ (((ob >> 9) & 1) << 5)); }
__host__ __device__ __forceinline__ void stage_rc(int b, int& R, int& C) { const int st = b / 1024, sb = b % 1024, swz = sb ^ (((sb >> 9) & 1) << 5); R = (st >> 1) * 16 + swz / 64; C = (st & 1) * 32 + (swz % 64) / 2; }
__host__ __device__ __forceinline__ int perm32(int rho) { const int n = rho >> 4, i = rho & 15; return 8 * (i >> 2) + 4 * n + (i & 3); }

struct Unit { int pm, pn; };
struct Gemm { const bf16_t* A; const bf16_t* Bt; int M, N, K; };

struct StaticOrder {
    int nM, nN, nwg, G, c;
    __host__ __device__ void init(int M, int N, int G_, int c_) { nM = M / BM; nN = N / BM; nwg = nM * nN; G = G_; c = c_; }
    __host__ __device__ bool next(int i, Unit& u) const {
        const long L = (long)i * G + c; if (L >= nwg) return false;
        int wgid = (int)L; { const int q = nwg / NXCD, r = nwg % NXCD, xcd = wgid % NXCD, off = wgid / NXCD; wgid = (xcd < r ? xcd * (q + 1) : r * (q + 1) + (xcd - r) * q) + off; }
        const int nig = WGM * nN, gid = wgid / nig, fm = gid * WGM, gsz = (nM - fm) < WGM ? (nM - fm) : WGM;
        u.pm = fm + ((wgid % nig) % gsz); u.pn = (wgid % nig) / gsz; return true;
    }
    __device__ __forceinline__ void a_ready(const Unit&) const {}
    __device__ __forceinline__ void done(const Unit&) const {}
};

__device__ __forceinline__ unsigned cvt_pk_bf16(float lo, float hi) { unsigned r; asm volatile("v_cvt_pk_bf16_f32 %0, %1, %2" : "=v"(r) : "v"(lo), "v"(hi)); return r; }
typedef float f32x2 __attribute__((ext_vector_type(2)));
template <class Epi, class Sched, bool ALIGN_EPI = false, bool SP2 = false>
__device__ __forceinline__ void gemm_phase(PG8_LAS unsigned char* lds, const Gemm g, const Sched& S, const Epi& E) {
    const int tid = threadIdx.x, wid = __builtin_amdgcn_readfirstlane(tid >> 6), lane = tid & 63, wr = wid >> 2, wc = wid & 3, fr = lane & 15, fq = lane >> 4;
    const int K = g.K, nt = K / BK;
    unsigned voffA[2], voffB[2];
#pragma unroll
    for (int i = 0; i < 2; ++i) { int R, C; stage_rc(tid * 16 + i * 8192, R, C); const int Rb = Epi::PERM ? ((R & ~31) + perm32(R & 31)) : R;
        voffA[i] = (unsigned)(R * K + C) * 2u; voffB[i] = (unsigned)(Rb * K + C) * 2u; }
    const size_t kstep = (size_t)(BK * 2);
    const size_t hstep = (size_t)HALF * K * 2;
    const size_t tstep = 2 * hstep;
    const unsigned ldsw = (unsigned)wid * 1024u;
    const int aoff = lds_byte(wr * 64 + fr, fq * 8), boff = lds_byte(wc * 32 + fr, fq * 8);
#define PG8_SA(b, h) (((b) * 2 + (h)) * HTB)
#define PG8_SB(b, h) ((4 + (b) * 2 + (h)) * HTB)
#define PG8_STAGE(bufoff, gbase, voff) do { _Pragma("unroll") for (int _i = 0; _i < 2; ++_i) \
        __builtin_amdgcn_global_load_lds((const unsigned*)((const char*)(gbase) + (voff)[_i]), (PG8_LAS unsigned*)(lds + (bufoff) + ldsw + _i * 8192), 16, 0, 0); } while (0)
#define PG8_LDA(dst, b, h) do { _Pragma("unroll") for (int m = 0; m < 4; ++m) _Pragma("unroll") for (int k = 0; k < 2; ++k) dst[m][k] = *(const PG8_LAS bf16x8*)(lds + PG8_SA(b, h) + aoff + m * 2048 + k * 1024); } while (0)
#define PG8_LDB(dst, b, h) do { _Pragma("unroll") for (int n = 0; n < 2; ++n) _Pragma("unroll") for (int k = 0; k < 2; ++k) dst[n][k] = *(const PG8_LAS bf16x8*)(lds + PG8_SB(b, h) + boff + n * 2048 + k * 1024); } while (0)
#define PG8_MMA(ai, bj, At, Bt) do { __builtin_amdgcn_s_setprio(1); _Pragma("unroll") for (int m = 0; m < 4; ++m) _Pragma("unroll") for (int n = 0; n < 2; ++n) _Pragma("unroll") for (int k = 0; k < 2; ++k) \
        acc[ai][bj][m][n] = __builtin_amdgcn_mfma_f32_16x16x32_bf16(Bt[n][k], At[m][k], acc[ai][bj][m][n], 0, 0, 0); __builtin_amdgcn_s_setprio(0); } while (0)
#define PG8_WAIT_V(n) asm volatile("s_waitcnt vmcnt(" #n ")" ::: "memory")
#define PG8_WAIT_L(n) asm volatile("s_waitcnt lgkmcnt(" #n ")" ::: "memory")
#define PG8_BAR __builtin_amdgcn_s_barrier()
#define PG8_SCHED __builtin_amdgcn_sched_barrier(0)
    Unit cur, nxt; int ui = 0;
    if (!S.next(0, cur)) return;
    f32x4 acc[2][2][4][2];
#pragma unroll
    for (int a = 0; a < 2; ++a)
#pragma unroll
        for (int b = 0; b < 2; ++b)
#pragma unroll
            for (int m = 0; m < 4; ++m)
#pragma unroll
                for (int n = 0; n < 2; ++n) acc[a][b][m][n] = (f32x4){0.f, 0.f, 0.f, 0.f};
    bf16x8 At[4][2], B0[2][2], B1[2][2];
    const char* cA = (const char*)g.A + (size_t)cur.pm * tstep; const char* cB = (const char*)g.Bt + (size_t)cur.pn * tstep;
    S.a_ready(cur);
    if constexpr (SP2) {
        PG8_STAGE(PG8_SB(0, 0), cB, voffB); PG8_STAGE(PG8_SB(0, 1), cB + hstep, voffB); PG8_STAGE(PG8_SA(0, 0), cA, voffA); PG8_STAGE(PG8_SA(0, 1), cA + hstep, voffA);
        if (wr == 1) PG8_BAR;
        PG8_WAIT_V(2); PG8_BAR;
        PG8_STAGE(PG8_SB(1, 0), cB + kstep, voffB); PG8_STAGE(PG8_SA(1, 0), cA + kstep, voffA); PG8_STAGE(PG8_SB(1, 1), cB + hstep + kstep, voffB);
        PG8_WAIT_V(6); PG8_BAR;
    } else {
        PG8_STAGE(PG8_SB(0, 0), cB, voffB); PG8_STAGE(PG8_SA(0, 0), cA, voffA); PG8_STAGE(PG8_SB(0, 1), cB + hstep, voffB); PG8_STAGE(PG8_SA(0, 1), cA + hstep, voffA);
        if (wr == 1) PG8_BAR;
        PG8_WAIT_V(4); PG8_BAR;
        PG8_STAGE(PG8_SB(1, 0), cB + kstep, voffB); PG8_STAGE(PG8_SA(1, 0), cA + kstep, voffA); PG8_STAGE(PG8_SB(1, 1), cB + hstep + kstep, voffB);
        PG8_WAIT_V(6); PG8_BAR;
    }
    for (;;) {
        const bool has_next = S.next(ui + 1, nxt);
        const char* nA = has_next ? (const char*)g.A + (size_t)nxt.pm * tstep : cA; const char* nB = has_next ? (const char*)g.Bt + (size_t)nxt.pn * tstep : cB;
        for (int t = 0; t < nt; t += 2) {
            const bool last = (t == nt - 2);
            const char* a1 = cA + (size_t)(t + 1) * kstep;
            const char* a2 = last ? nA : cA + (size_t)(t + 2) * kstep; const char* b2 = last ? nB : cB + (size_t)(t + 2) * kstep;
            const char* a3 = a2 + kstep; const char* b3 = b2 + kstep;
            if (last && has_next) S.a_ready(nxt);
            if constexpr (SP2) {
            PG8_LDB(B0, 0, 0); PG8_LDB(B1, 0, 1); PG8_SCHED; PG8_LDA(At, 0, 0); PG8_STAGE(PG8_SA(1, 1), a1 + hstep, voffA);
            PG8_WAIT_V(8); PG8_WAIT_L(0); PG8_BAR; PG8_MMA(0, 0, At, B0); PG8_MMA(0, 1, At, B1); PG8_BAR; PG8_SCHED;
            PG8_LDA(At, 0, 1); PG8_STAGE(PG8_SB(0, 0), b2, voffB); PG8_STAGE(PG8_SB(0, 1), b2 + hstep, voffB); PG8_STAGE(PG8_SA(0, 0), a2, voffA);
            PG8_WAIT_V(8); PG8_WAIT_L(0); PG8_BAR; PG8_MMA(1, 0, At, B0); PG8_MMA(1, 1, At, B1); PG8_BAR; PG8_SCHED;
            PG8_LDB(B0, 1, 0); PG8_LDB(B1, 1, 1); PG8_SCHED; PG8_LDA(At, 1, 0); PG8_STAGE(PG8_SA(0, 1), a2 + hstep, voffA);
            PG8_WAIT_V(8); PG8_WAIT_L(0); PG8_BAR; PG8_MMA(0, 0, At, B0); PG8_MMA(0, 1, At, B1); PG8_BAR; PG8_SCHED;
            PG8_LDA(At, 1, 1); PG8_STAGE(PG8_SB(1, 0), b3, voffB); PG8_STAGE(PG8_SB(1, 1), b3 + hstep, voffB); PG8_STAGE(PG8_SA(1, 0), a3, voffA);
            PG8_WAIT_V(8); PG8_WAIT_L(0); PG8_BAR; PG8_MMA(1, 0, At, B0); PG8_MMA(1, 1, At, B1); PG8_BAR; PG8_SCHED;
            } else {
            PG8_LDB(B0, 0, 0); PG8_SCHED; PG8_LDA(At, 0, 0); PG8_STAGE(PG8_SA(1, 1), a1 + hstep, voffA);
            PG8_WAIT_L(8); PG8_BAR; PG8_WAIT_L(0); PG8_MMA(0, 0, At, B0); PG8_BAR; PG8_SCHED;
            PG8_LDB(B1, 0, 1); PG8_STAGE(PG8_SB(0, 0), b2, voffB);
            PG8_BAR; PG8_WAIT_L(0); PG8_MMA(0, 1, At, B1); PG8_BAR;
            PG8_LDA(At, 0, 1); PG8_STAGE(PG8_SA(0, 0), a2, voffA);
            PG8_BAR; PG8_WAIT_L(0); PG8_MMA(1, 0, At, B0); PG8_BAR; PG8_SCHED;
            PG8_STAGE(PG8_SB(0, 1), b2 + hstep, voffB);
            PG8_WAIT_V(6); PG8_BAR; PG8_MMA(1, 1, At, B1); PG8_BAR;
            PG8_LDB(B0, 1, 0); PG8_SCHED; PG8_LDA(At, 1, 0); PG8_STAGE(PG8_SA(0, 1), a2 + hstep, voffA);
            PG8_WAIT_L(8); PG8_BAR; PG8_WAIT_L(0); PG8_MMA(0, 0, At, B0); PG8_BAR; PG8_SCHED;
            PG8_LDB(B1, 1, 1); PG8_STAGE(PG8_SB(1, 0), b3, voffB);
            PG8_BAR; PG8_WAIT_L(0); PG8_MMA(0, 1, At, B1); PG8_BAR;
            PG8_LDA(At, 1, 1); PG8_STAGE(PG8_SA(1, 0), a3, voffA);
            PG8_BAR; PG8_WAIT_L(0); PG8_MMA(1, 0, At, B0); PG8_BAR; PG8_SCHED;
            PG8_STAGE(PG8_SB(1, 1), b3 + hstep, voffB);
            PG8_WAIT_V(6); PG8_BAR; PG8_MMA(1, 1, At, B1); PG8_BAR;
            }
        }
        if constexpr (ALIGN_EPI) { if (wr == 0) PG8_BAR; }
        if constexpr (!Epi::AFTER_DRAIN) { E(acc, cur, wr, wc, fr, fq); S.done(cur); }
        if (!has_next) break;
#pragma unroll
        for (int a = 0; a < 2; ++a)
#pragma unroll
            for (int b = 0; b < 2; ++b)
#pragma unroll
                for (int m = 0; m < 4; ++m)
#pragma unroll
                    for (int n = 0; n < 2; ++n) acc[a][b][m][n] = (f32x4){0.f, 0.f, 0.f, 0.f};
        cur = nxt; cA = nA; cB = nB; ++ui;
        if constexpr (ALIGN_EPI) { if (wr == 1) PG8_BAR; }
    }
    PG8_WAIT_V(0);
    if constexpr (!ALIGN_EPI) { if (wr == 0) PG8_BAR; }
    PG8_BAR;
    if constexpr (Epi::AFTER_DRAIN) { E.fused(acc, cur, wr, wc, fr, fq, lds, wid, lane); S.done(cur); }
#undef PG8_SA
#undef PG8_SB
#undef PG8_STAGE
#undef PG8_LDA
#undef PG8_LDB
#undef PG8_MMA
#undef PG8_WAIT_V
#undef PG8_WAIT_L
#undef PG8_BAR
#undef PG8_SCHED
}
}

#ifndef MK_COOP
#define MK_COOP 1
#endif

#define LAS __attribute__((address_space(3)))
typedef pg8::f32x4 f32x4;
typedef pg8::bf16_t bf16_t;
typedef pg8::bf16x8 bf16x8;
typedef unsigned u32x2 __attribute__((ext_vector_type(2)));
typedef unsigned u32x4 __attribute__((ext_vector_type(4)));

constexpr int DM = 1024, SEQ = 4096, NBATCH = 8, MP = NBATCH * SEQ, MS = 128, MT = MP + MS;
constexpr int FF = 2816, NIN = 1792, PLE = 256;
constexpr float RMS_EPS = 1e-6f, LN_EPS = 1e-5f;
constexpr int NPHASE = 10;

constexpr size_t O_Y = 0, O_KWP = (size_t)MT * DM, O_VWP = O_KWP + 131072, O_KWS = O_VWP + 131072, O_VWS = O_KWS + 2097152,
                 O_GVP = O_VWS + 2097152, O_GVS = O_GVP + 524288, O_END = O_GVS + 65536;

constexpr size_t al256(size_t x) { return (x + 255) & ~(size_t)255; }
constexpr size_t WS_W13A = 0;
constexpr size_t WS_W2A = al256(WS_W13A + (size_t)2 * FF * DM * 2);
constexpr size_t WS_W13B = al256(WS_W2A + (size_t)DM * FF * 2);
constexpr size_t WS_W2B = al256(WS_W13B + (size_t)2 * FF * DM * 2);
constexpr size_t WS_WIN = al256(WS_W2B + (size_t)DM * FF * 2);
constexpr size_t WS_WOUT = al256(WS_WIN + (size_t)NIN * DM * 2);
constexpr size_t WS_WG = al256(WS_WOUT + (size_t)DM * DM * 2);
constexpr size_t WS_WP = al256(WS_WG + (size_t)DM * DM * 2);
constexpr size_t WS_XB = al256(WS_WP + (size_t)DM * PLE * 2);
constexpr size_t WS_PB = al256(WS_XB + (size_t)MT * DM * 2);
constexpr size_t WS_PP = al256(WS_PB + (size_t)MT * PLE * 2);
constexpr size_t WS_SS = al256(WS_PP + (size_t)MT * DM * 2);
constexpr size_t WS_LNP = al256(WS_SS + (size_t)MT * 16 * 4);
constexpr size_t WS_H = al256(WS_LNP + (size_t)MT * 16 * 4);
constexpr size_t WS_Q = WS_H;
constexpr size_t WS_K = WS_Q + (size_t)MT * 512 * 2;
constexpr size_t WS_V = WS_K + (size_t)MT * 128 * 2;
constexpr size_t WS_GU = WS_V + (size_t)MT * 128 * 2;
constexpr size_t WS_GV = WS_GU + (size_t)MT * 512 * 2;
constexpr size_t WS_AB = WS_GV + (size_t)MT * 512 * 2;
constexpr size_t WS_END = al256(WS_H + (size_t)MT * FF * 2);
static_assert(WS_AB + (size_t)MT * DM * 2 <= WS_END, "overlay fits in h");

constexpr int LDS_BYTES = 147456;

__device__ __forceinline__ float bf2f(unsigned short b) { return __uint_as_float((unsigned)b << 16); }
__device__ __forceinline__ float fast_exp(float x) { return __builtin_amdgcn_exp2f(x * 1.44269504089f); }
__device__ __forceinline__ float sigmoid_(float x) { return __builtin_amdgcn_rcpf(1.f + fast_exp(-x)); }
__device__ __forceinline__ float silu_(float x) { return x * sigmoid_(x); }
__device__ __forceinline__ float gelu_(float x) { return x * sigmoid_(1.5957691216f * (x + 0.044715f * x * x * x)); }
__device__ __forceinline__ u32x2 pack4(f32x4 v) { u32x2 w; w.x = pg8::cvt_pk_bf16(v[0], v[1]); w.y = pg8::cvt_pk_bf16(v[2], v[3]); return w; }
__device__ __forceinline__ f32x4 unpack4(u32x2 w) { return (f32x4){__uint_as_float(w.x << 16), __uint_as_float(w.x & 0xffff0000u), __uint_as_float(w.y << 16), __uint_as_float(w.y & 0xffff0000u)}; }
__device__ __forceinline__ float dot4(f32x4 a, f32x4 b) { return (a[0] * b[0] + a[1] * b[1]) + (a[2] * b[2] + a[3] * b[3]); }

struct QSwiglu {
    static constexpr bool NEED_R = true, SWI = true, STAT = false;
    bf16_t* H;
    __device__ __forceinline__ void quad2(int row, int col, float r, f32x4 a, f32x4 b) const {
        f32x4 o;
#pragma unroll
        for (int i = 0; i < 4; ++i) o[i] = silu_(a[i] * r) * (b[i] * r);
        *(u32x2*)(H + (size_t)row * FF + col) = pack4(o);
    }
};
struct QResid {
    static constexpr bool NEED_R = false, SWI = false, STAT = true;
    const float* base_p; const float* base_s; float* X; bf16_t* XB; const float* bias; float* SS; float scale;
    __device__ __forceinline__ float quad(int row, int col, float r, f32x4 v, float& s1) const {
        s1 = 0.f;
        const float* bp = row < MP ? base_p + (size_t)row * DM : base_s + (size_t)(row - MP) * DM;
        f32x4 o = *(const f32x4*)(bp + col) + v * scale;
        if (bias) o = o + *(const f32x4*)(bias + col);
        *(f32x4*)(X + (size_t)row * DM + col) = o;
        *(u32x2*)(XB + (size_t)row * DM + col) = pack4(o);
        return dot4(o, o);
    }
    __device__ __forceinline__ void rowstat(int row, int pn, int wc, float s0, float s1) const { SS[(size_t)row * 16 + pn * 4 + wc] = s0; }
};
struct QWin {
    static constexpr bool NEED_R = true, SWI = false, STAT = true;
    const float* bias; bf16_t *Q, *K, *V, *GU, *GV; float* LNP; float* out;
    __device__ __forceinline__ float quad(int row, int col, float r, f32x4 v, float& s1) const {
        const f32x4 z = v * r + *(const f32x4*)(bias + col);
        s1 = 0.f;
        const int cb = __builtin_amdgcn_readfirstlane(col >> 7);
        if (cb < 4) { *(u32x2*)(Q + (size_t)row * 512 + col) = pack4(z * 0.125f); return 0.f; }
        if (cb < 6) {
            const bool isk = cb == 4; const int c = col - (isk ? 512 : 640);
            *(u32x2*)((isk ? K : V) + (size_t)row * 128 + c) = pack4(z);
            if (row >= MP) { *(f32x4*)(out + (isk ? O_KWS : O_VWS) + ((size_t)(row - MP) * 128 + 127) * 128 + c) = z; }
            else { const int t = row & (SEQ - 1); if (t >= SEQ - 128) *(f32x4*)(out + (isk ? O_KWP : O_VWP) + ((size_t)(row >> 12) * 128 + (t - (SEQ - 128))) * 128 + c) = z; }
            return 0.f;
        }
        f32x4 g;
#pragma unroll
        for (int i = 0; i < 4; ++i) g[i] = gelu_(z[i]);
        if (cb < 10) { *(u32x2*)(GU + (size_t)row * 512 + (col - 768)) = pack4(g); return 0.f; }
        *(u32x2*)(GV + (size_t)row * 512 + (col - 1280)) = pack4(g);
        s1 = dot4(g, g);
        return (g[0] + g[1]) + (g[2] + g[3]);
    }
    __device__ __forceinline__ void rowstat(int row, int pn, int wc, float s0, float s1) const {
        if (pn >= 5) { float* p = LNP + (size_t)row * 16 + ((pn - 5) * 4 + wc) * 2; p[0] = s0; p[1] = s1; }
    }
};
struct QProj {
    static constexpr bool NEED_R = false, SWI = false, STAT = false;
    bf16_t* PP;
    __device__ __forceinline__ float quad(int row, int col, float r, f32x4 v, float& s1) const { s1 = 0.f; *(u32x2*)(PP + (size_t)row * DM + col) = pack4(v); return 0.f; }
};
struct QGate {
    static constexpr bool NEED_R = true, SWI = false, STAT = false;
    float* X; const bf16_t* PP;
    __device__ __forceinline__ float quad(int row, int col, float r, f32x4 v, float& s1) const {
        s1 = 0.f;
        const f32x4 pp = unpack4(*(const u32x2*)(PP + (size_t)row * DM + col));
        f32x4 x = *(const f32x4*)(X + (size_t)row * DM + col);
#pragma unroll
        for (int i = 0; i < 4; ++i) x[i] += sigmoid_(v[i] * r) * pp[i];
        *(f32x4*)(X + (size_t)row * DM + col) = x;
        return 0.f;
    }
};

template <class Q> struct EpiMain {
    static constexpr bool PERM = false, AFTER_DRAIN = false;
    Q q; const float* ss;
    __device__ __forceinline__ void operator()(const f32x4 (&acc)[2][2][4][2], const pg8::Unit& u, int wr, int wc, int fr, int fq) const {
#pragma unroll
        for (int ai = 0; ai < 2; ++ai)
#pragma unroll
            for (int m = 0; m < 4; ++m) {
                const int row = u.pm * 256 + ai * 128 + wr * 64 + m * 16 + fr;
                float r = 1.f;
                if constexpr (Q::NEED_R) {
                    const f32x4 p = *(const f32x4*)(ss + (size_t)row * 16 + 4 * fq);
                    float s = (p[0] + p[1]) + (p[2] + p[3]); s += __shfl_xor(s, 16); s += __shfl_xor(s, 32);
                    r = __builtin_amdgcn_rsqf(s * (1.0f / DM) + RMS_EPS);
                }
                if constexpr (Q::SWI) {
#pragma unroll
                    for (int n = 0; n < 2; ++n) q.quad2(row, u.pn * 128 + wc * 32 + n * 16 + 4 * fq, r, acc[ai][0][m][n], acc[ai][1][m][n]);
                } else {
                    float s0 = 0.f, s1 = 0.f;
#pragma unroll
                    for (int bj = 0; bj < 2; ++bj)
#pragma unroll
                        for (int n = 0; n < 2; ++n) {
                            const int col = u.pn * 256 + bj * 128 + wc * 32 + n * 16 + 4 * fq;
                            float t1; s0 += q.quad(row, col, r, acc[ai][bj][m][n], t1); s1 += t1;
                        }
                    if constexpr (Q::STAT) {
                        s0 += __shfl_xor(s0, 16); s0 += __shfl_xor(s0, 32);
                        s1 += __shfl_xor(s1, 16); s1 += __shfl_xor(s1, 32);
                        if (fq == 0) q.rowstat(row, u.pn, wc, s0, s1);
                    }
                }
                asm volatile("" ::: "memory");
            }
    }
};

struct UpperOrder {
    int nN, total, c, off, G2;
    __device__ void init(int M, int N, int G, int c_) { nN = N / 256; total = (M / 256) * nN; off = G / 2; G2 = G - off; c = c_; }
    __device__ bool next(int i, pg8::Unit& u) const { if (c < off) return false; const int L = i * G2 + (c - off); if (L >= total) return false; u.pm = L / nN; u.pn = L % nN; return true; }
    __device__ __forceinline__ void a_ready(const pg8::Unit&) const {}
    __device__ __forceinline__ void done(const pg8::Unit&) const {}
};

template <class Q>
__device__ __forceinline__ void skinny_gemm(LAS unsigned char* lds, const bf16_t* A, const bf16_t* Bt, int N, int K, const Q& q, int item0, int item_stride) {
    const int tid = threadIdx.x, wid = __builtin_amdgcn_readfirstlane(tid >> 6), lane = tid & 63, fr = lane & 15, fq = lane >> 4;
    LAS f32x4* red = (LAS f32x4*)lds;
    LAS float* redsq = (LAS float*)(lds + 65536);
    const int nitems = (N / 16) * 2, kw = K / 8, nsteps = kw / 32;
    for (int item = item0; item < nitems; item += item_stride) {
        const int nb = item >> 1, rh = item & 1;
        size_t brow0, brow1 = 0;
        if constexpr (Q::SWI) { const int hc = nb * 16 + fr; brow0 = (size_t)((hc >> 7) * 256 + (hc & 127)); brow1 = brow0 + 128; }
        else brow0 = (size_t)(nb * 16 + fr);
        f32x4 acc0[4], acc1[4]; float sq[4];
#pragma unroll
        for (int rt = 0; rt < 4; ++rt) { acc0[rt] = (f32x4){0.f, 0.f, 0.f, 0.f}; acc1[rt] = (f32x4){0.f, 0.f, 0.f, 0.f}; sq[rt] = 0.f; }
        const bf16_t* ap = A + (size_t)(rh * 64 + fr) * K + wid * kw + fq * 8;
        const bf16_t* bp0 = Bt + brow0 * K + wid * kw + fq * 8;
        const bf16_t* bp1 = Bt + brow1 * K + wid * kw + fq * 8;
        for (int s = 0; s < nsteps; ++s) {
            const bf16x8 b0 = *(const bf16x8*)(bp0 + s * 32);
            bf16x8 b1; if constexpr (Q::SWI) b1 = *(const bf16x8*)(bp1 + s * 32);
#pragma unroll
            for (int rt = 0; rt < 4; ++rt) {
                const bf16x8 a = *(const bf16x8*)(ap + (size_t)rt * 16 * K + s * 32);
                acc0[rt] = __builtin_amdgcn_mfma_f32_16x16x32_bf16(b0, a, acc0[rt], 0, 0, 0);
                if constexpr (Q::SWI) acc1[rt] = __builtin_amdgcn_mfma_f32_16x16x32_bf16(b1, a, acc1[rt], 0, 0, 0);
                if constexpr (Q::NEED_R) {
#pragma unroll
                    for (int e = 0; e < 8; ++e) { const float f = bf2f((unsigned short)a[e]); sq[rt] += f * f; }
                }
            }
        }
#pragma unroll
        for (int rt = 0; rt < 4; ++rt) {
            red[((wid * 2 + 0) * 4 + rt) * 64 + lane] = acc0[rt];
            if constexpr (Q::SWI) red[((wid * 2 + 1) * 4 + rt) * 64 + lane] = acc1[rt];
            if constexpr (Q::NEED_R) redsq[(wid * 4 + rt) * 64 + lane] = sq[rt];
        }
        __syncthreads();
        if (tid < 256) {
            const int rt = tid >> 6;
            f32x4 v0 = (f32x4){0.f, 0.f, 0.f, 0.f}, v1 = (f32x4){0.f, 0.f, 0.f, 0.f};
#pragma unroll
            for (int w = 0; w < 8; ++w) { v0 = v0 + red[((w * 2 + 0) * 4 + rt) * 64 + lane]; if constexpr (Q::SWI) v1 = v1 + red[((w * 2 + 1) * 4 + rt) * 64 + lane]; }
            float r = 1.f;
            if constexpr (Q::NEED_R) {
                float s = 0.f;
#pragma unroll
                for (int w = 0; w < 8; ++w)
#pragma unroll
                    for (int f = 0; f < 4; ++f) s += redsq[(w * 4 + rt) * 64 + f * 16 + fr];
                r = __builtin_amdgcn_rsqf(s * (1.0f / (float)K) + RMS_EPS);
            }
            const int row = MP + rh * 64 + rt * 16 + fr, col = nb * 16 + 4 * fq;
            if constexpr (Q::SWI) q.quad2(row, col, r, v0, v1); else { float t1; (void)q.quad(row, col, r, v0, t1); }
        }
        __syncthreads();
    }
}

__device__ __forceinline__ void p0_transpose_item(const float* W, int K, int N, const float* gk, bf16_t* WT, int mode, LAS float* scr, int item, int lane) {
    const int nblk = N / 32, kb = item / nblk, nb = item % nblk, k0 = 64 * kb, n0 = 32 * nb;
#pragma unroll 8
    for (int i = 0; i < 32; ++i) { const int kk = 2 * i + (lane >> 5); float w = W[(size_t)(k0 + kk) * N + n0 + (lane & 31)]; if (gk) w *= gk[k0 + kk]; scr[kk * 33 + (lane & 31)] = w; }
    asm volatile("s_waitcnt lgkmcnt(0)" ::: "memory");
    const int drow0 = mode == 0 ? n0 : ((n0 >> 7) * 256 + (n0 & 127) + (mode == 2 ? 128 : 0));
    const int c = lane & 7;
#pragma unroll
    for (int j = 0; j < 4; ++j) { const int n = (lane >> 3) + 8 * j; const LAS float* s = scr + (8 * c) * 33 + n;
        u32x4 o; o.x = pg8::cvt_pk_bf16(s[0 * 33], s[1 * 33]); o.y = pg8::cvt_pk_bf16(s[2 * 33], s[3 * 33]); o.z = pg8::cvt_pk_bf16(s[4 * 33], s[5 * 33]); o.w = pg8::cvt_pk_bf16(s[6 * 33], s[7 * 33]);
        *(u32x4*)(WT + (size_t)(drow0 + n) * K + k0 + 8 * c) = o; }
    asm volatile("s_waitcnt lgkmcnt(0)" ::: "memory");
}

struct Args { const float* in[28]; float* out; unsigned char* ws; int ph_lo, ph_hi; };

__device__ __forceinline__ void p0_prologue(const Args& a, LAS unsigned char* lds, int wid, int lane) {
    unsigned char* ws = a.ws;
    LAS float* scr = (LAS float*)(lds + wid * 16384);
    const int gw = blockIdx.x * 8 + wid, NGW = gridDim.x * 8;
    constexpr int I13 = (DM / 64) * (FF / 32), I2 = (FF / 64) * (DM / 32), IIN = (DM / 64) * (NIN / 32), ISQ = (DM / 64) * (DM / 32), IP = (PLE / 64) * (DM / 32);
    constexpr int NITEMS = 4 * I13 + 2 * I2 + IIN + 2 * ISQ + IP;
    for (int it = gw; it < NITEMS; it += NGW) {
        int r = it;
        if (r < I13) { p0_transpose_item(a.in[7], DM, FF, a.in[6], (bf16_t*)(ws + WS_W13A), 1, scr, r, lane); continue; } r -= I13;
        if (r < I13) { p0_transpose_item(a.in[8], DM, FF, a.in[6], (bf16_t*)(ws + WS_W13A), 2, scr, r, lane); continue; } r -= I13;
        if (r < I13) { p0_transpose_item(a.in[21], DM, FF, a.in[20], (bf16_t*)(ws + WS_W13B), 1, scr, r, lane); continue; } r -= I13;
        if (r < I13) { p0_transpose_item(a.in[22], DM, FF, a.in[20], (bf16_t*)(ws + WS_W13B), 2, scr, r, lane); continue; } r -= I13;
        if (r < I2) { p0_transpose_item(a.in[9], FF, DM, nullptr, (bf16_t*)(ws + WS_W2A), 0, scr, r, lane); continue; } r -= I2;
        if (r < I2) { p0_transpose_item(a.in[23], FF, DM, nullptr, (bf16_t*)(ws + WS_W2B), 0, scr, r, lane); continue; } r -= I2;
        if (r < IIN) { p0_transpose_item(a.in[11], DM, NIN, a.in[10], (bf16_t*)(ws + WS_WIN), 0, scr, r, lane); continue; } r -= IIN;
        if (r < ISQ) { p0_transpose_item(a.in[18], DM, DM, nullptr, (bf16_t*)(ws + WS_WOUT), 0, scr, r, lane); continue; } r -= ISQ;
        if (r < ISQ) { p0_transpose_item(a.in[25], DM, DM, a.in[24], (bf16_t*)(ws + WS_WG), 0, scr, r, lane); continue; } r -= ISQ;
        p0_transpose_item(a.in[26], PLE, DM, nullptr, (bf16_t*)(ws + WS_WP), 0, scr, r, lane);
    }
    bf16_t* XB = (bf16_t*)(ws + WS_XB); float* SS = (float*)(ws + WS_SS); bf16_t* PB = (bf16_t*)(ws + WS_PB);
    for (int m = gw; m < MT; m += NGW) {
        const float* xr = m < MP ? a.in[0] + (size_t)m * DM : a.in[1] + (size_t)(m - MP) * DM;
        const float* pr = m < MP ? a.in[4] + (size_t)m * PLE : a.in[5] + (size_t)(m - MP) * PLE;
        f32x4 v[4];
#pragma unroll
        for (int j = 0; j < 4; ++j) v[j] = ((const f32x4*)xr)[lane + 64 * j];
        const f32x4 pv = ((const f32x4*)pr)[lane];
#pragma unroll
        for (int j = 0; j < 4; ++j) {
            ((u32x2*)(XB + (size_t)m * DM))[lane + 64 * j] = pack4(v[j]);
            float s = dot4(v[j], v[j]);
            s += __shfl_xor(s, 1); s += __shfl_xor(s, 2); s += __shfl_xor(s, 4); s += __shfl_xor(s, 8);
            if ((lane & 15) == 0) SS[(size_t)m * 16 + 4 * j + (lane >> 4)] = s;
        }
        ((u32x2*)(PB + (size_t)m * PLE))[lane] = pack4(pv);
    }
    {
        const int gt = blockIdx.x * 512 + threadIdx.x, NT = gridDim.x * 512;
        constexpr int NV = MS * 127 * 32;
        for (int i = gt; i < 2 * NV; i += NT) {
            const int which = i >= NV, j = which ? i - NV : i;
            const int b = j / (127 * 32), rem = j % (127 * 32), w = rem >> 5, c4 = rem & 31;
            const float* src = a.in[2 + which] + ((size_t)(b * 128 + w + 1) * 128 + c4 * 4);
            float* dst = a.out + (which ? O_VWS : O_KWS) + ((size_t)(b * 128 + w) * 128 + c4 * 4);
            *(f32x4*)dst = *(const f32x4*)src;
        }
    }
}

constexpr int KS_PITCH = 72, VT_PITCH = 264, VN_PITCH = 136;
__device__ __forceinline__ void attn_unit(LAS unsigned char* lds, int b, int h, int n, const bf16_t* Q, const bf16_t* Kb, const bf16_t* Vb, bf16_t* AB, const float* sinks) {
    const int tid = threadIdx.x, wid = __builtin_amdgcn_readfirstlane(tid >> 6), lane = tid & 63, fr = lane & 15, fq = lane >> 4;
    LAS bf16_t* Ks = (LAS bf16_t*)lds;
    LAS bf16_t* Vt = (LAS bf16_t*)(lds + 256 * KS_PITCH * 2);
    const bf16x8 zero8 = (bf16x8){0, 0, 0, 0, 0, 0, 0, 0};
    {
        const int key = tid >> 1, half = tid & 1, kpos = (n - 1) * 128 + key;
        bf16x8 v[4];
#pragma unroll
        for (int j = 0; j < 4; ++j) v[j] = zero8;
        if (kpos >= 0) { const bf16x8* src = (const bf16x8*)(Kb + (size_t)(b * SEQ + kpos) * 128 + h * 64 + half * 32);
#pragma unroll
            for (int j = 0; j < 4; ++j) v[j] = src[j]; }
#pragma unroll
        for (int j = 0; j < 4; ++j) *(LAS bf16x8*)(Ks + key * KS_PITCH + half * 32 + j * 8) = v[j];
    }
#pragma unroll
    for (int t2 = 0; t2 < 2; ++t2) {
        const int task = tid + 512 * t2, kp = task & 127, dc = task >> 7, c = 2 * kp, kpos = (n - 1) * 128 + c;
        bf16x8 v0 = zero8, v1 = zero8;
        if (kpos >= 0) { const bf16_t* src = Vb + (size_t)(b * SEQ + kpos) * 128 + h * 64 + dc * 8; v0 = *(const bf16x8*)src; v1 = *(const bf16x8*)(src + 128); }
#pragma unroll
        for (int e = 0; e < 8; ++e) *(LAS unsigned*)(Vt + (dc * 8 + e) * VT_PITCH + c) = (unsigned)(unsigned short)v0[e] | ((unsigned)(unsigned short)v1[e] << 16);
    }
    __syncthreads();
    const int g = wid >> 1, ph = wid & 1, hq = h * 4 + g;
    const float sink = sinks[hq];
    for (int mt = 0; mt < 4; ++mt) {
        const int p0 = ph * 64 + mt * 16, p = p0 + fr, kt0 = p0 >> 5;
        const size_t qrow = (size_t)(b * SEQ + n * 128 + p);
        bf16x8 qf[2];
#pragma unroll
        for (int kd = 0; kd < 2; ++kd) qf[kd] = *(const bf16x8*)(Q + qrow * 512 + hq * 64 + kd * 32 + fq * 8);
        f32x4 s[5][2];
#pragma unroll
        for (int j = 0; j < 5; ++j)
#pragma unroll
            for (int hh = 0; hh < 2; ++hh) {
                const int c0 = 32 * (kt0 + j) + 16 * hh;
                f32x4 acc = (f32x4){0.f, 0.f, 0.f, 0.f};
#pragma unroll
                for (int kd = 0; kd < 2; ++kd) { const bf16x8 kf = *(const LAS bf16x8*)(Ks + (c0 + fr) * KS_PITCH + kd * 32 + fq * 8); acc = __builtin_amdgcn_mfma_f32_16x16x32_bf16(kf, qf[kd], acc, 0, 0, 0); }
                s[j][hh] = acc;
            }
        float mx = -INFINITY;
#pragma unroll
        for (int j = 0; j < 5; ++j)
#pragma unroll
            for (int hh = 0; hh < 2; ++hh)
#pragma unroll
                for (int i = 0; i < 4; ++i) {
                    const int c = 32 * (kt0 + j) + 16 * hh + 4 * fq + i;
                    const bool vis = (c >= p) && (c <= p + 128) && (n > 0 || c >= 128);
                    const float v = vis ? s[j][hh][i] : -INFINITY;
                    s[j][hh][i] = v; mx = fmaxf(mx, v);
                }
        mx = fmaxf(mx, __shfl_xor(mx, 16)); mx = fmaxf(mx, __shfl_xor(mx, 32)); mx = fmaxf(mx, sink);
        float sum = 0.f;
#pragma unroll
        for (int j = 0; j < 5; ++j)
#pragma unroll
            for (int hh = 0; hh < 2; ++hh)
#pragma unroll
                for (int i = 0; i < 4; ++i) { const float e = fast_exp(s[j][hh][i] - mx); s[j][hh][i] = e; sum += e; }
        sum += __shfl_xor(sum, 16); sum += __shfl_xor(sum, 32); sum += fast_exp(sink - mx);
        const float inv = 1.0f / sum;
        f32x4 o[4];
#pragma unroll
        for (int dt = 0; dt < 4; ++dt) o[dt] = (f32x4){0.f, 0.f, 0.f, 0.f};
#pragma unroll
        for (int j = 0; j < 5; ++j) {
            const u32x2 plo = pack4(s[j][0]), phi = pack4(s[j][1]);
            const u32x4 pw = (u32x4){plo.x, plo.y, phi.x, phi.y};
            const bf16x8 pf = __builtin_bit_cast(bf16x8, pw);
#pragma unroll
            for (int dt = 0; dt < 4; ++dt) {
                const LAS bf16_t* vp = Vt + (16 * dt + fr) * VT_PITCH + 32 * (kt0 + j) + 4 * fq;
                const u32x2 lo = *(const LAS u32x2*)vp, hi = *(const LAS u32x2*)(vp + 16);
                const u32x4 vw = (u32x4){lo.x, lo.y, hi.x, hi.y};
                o[dt] = __builtin_amdgcn_mfma_f32_16x16x32_bf16(__builtin_bit_cast(bf16x8, vw), pf, o[dt], 0, 0, 0);
            }
        }
#pragma unroll
        for (int dt = 0; dt < 4; ++dt) *(u32x2*)(AB + qrow * DM + hq * 64 + 16 * dt + 4 * fq) = pack4(o[dt] * inv);
    }
    __syncthreads();
}

__device__ __forceinline__ void gmlp_unit(LAS unsigned char* lds, int b, int n, int g, const bf16_t* GU, const bf16_t* GV, const float* LNP, bf16_t* AB,
                                          const float* ln_g, const float* ln_b, const float* w_s, const float* b_s, float* out) {
    const int tid = threadIdx.x, wid = __builtin_amdgcn_readfirstlane(tid >> 6), lane = tid & 63, fr = lane & 15, fq = lane >> 4;
    LAS bf16_t* vnT = (LAS bf16_t*)lds;
    const size_t row0 = (size_t)(b * SEQ + n * 128);
#pragma unroll
    for (int t2 = 0; t2 < 2; ++t2) {
        const int task = tid + 512 * t2, sp = task & 63, cc = task >> 6, s = 2 * sp;
        float mean[2], rstd[2]; f32x4 x[2][2];
#pragma unroll
        for (int rr = 0; rr < 2; ++rr) {
            const f32x4* lp = (const f32x4*)(LNP + (row0 + s + rr) * 16);
            float su = 0.f, sq = 0.f;
#pragma unroll
            for (int k = 0; k < 4; ++k) { const f32x4 t = lp[k]; su += t[0] + t[2]; sq += t[1] + t[3]; }
            mean[rr] = su * (1.0f / 512.0f);
            const float var = fmaxf(sq * (1.0f / 512.0f) - mean[rr] * mean[rr], 0.f);
            rstd[rr] = __builtin_amdgcn_rsqf(var + LN_EPS);
            const u32x4 w = *(const u32x4*)(GV + (row0 + s + rr) * 512 + g * 128 + cc * 8);
            x[rr][0] = unpack4((u32x2){w.x, w.y}); x[rr][1] = unpack4((u32x2){w.z, w.w});
        }
        const f32x4 g0 = *(const f32x4*)(ln_g + g * 128 + cc * 8), g1 = *(const f32x4*)(ln_g + g * 128 + cc * 8 + 4);
        const f32x4 b0 = *(const f32x4*)(ln_b + g * 128 + cc * 8), b1 = *(const f32x4*)(ln_b + g * 128 + cc * 8 + 4);
#pragma unroll
        for (int rr = 0; rr < 2; ++rr) { x[rr][0] = (x[rr][0] - mean[rr]) * rstd[rr] * g0 + b0; x[rr][1] = (x[rr][1] - mean[rr]) * rstd[rr] * g1 + b1; }
        if (n == SEQ / 128 - 1) {
#pragma unroll
            for (int rr = 0; rr < 2; ++rr) { float* o = out + O_GVP + ((size_t)(b * 128 + s + rr) * 512 + g * 128 + cc * 8); *(f32x4*)o = x[rr][0]; *(f32x4*)(o + 4) = x[rr][1]; }
        }
#pragma unroll
        for (int e = 0; e < 8; ++e) *(LAS unsigned*)(vnT + (cc * 8 + e) * VN_PITCH + s) = pg8::cvt_pk_bf16(x[0][e >> 2][e & 3], x[1][e >> 2][e & 3]);
    }
    __syncthreads();
    const int t = 16 * wid + fr, nks = (wid >> 1) + 1;
    f32x4 acc[8];
#pragma unroll
    for (int ct = 0; ct < 8; ++ct) acc[ct] = (f32x4){0.f, 0.f, 0.f, 0.f};
    for (int ks = 0; ks < nks; ++ks) {
        const int s0 = 32 * ks + 8 * fq;
        const float* wp = w_s + ((size_t)(g * 128 + t) * 128 + s0);
        const f32x4 w0 = *(const f32x4*)wp, w1 = *(const f32x4*)(wp + 4);
        float wv[8] = {w0[0], w0[1], w0[2], w0[3], w1[0], w1[1], w1[2], w1[3]};
#pragma unroll
        for (int e = 0; e < 8; ++e) wv[e] = (s0 + e <= t) ? wv[e] : 0.f;
        const u32x4 ww = (u32x4){pg8::cvt_pk_bf16(wv[0], wv[1]), pg8::cvt_pk_bf16(wv[2], wv[3]), pg8::cvt_pk_bf16(wv[4], wv[5]), pg8::cvt_pk_bf16(wv[6], wv[7])};
        const bf16x8 wf = __builtin_bit_cast(bf16x8, ww);
#pragma unroll
        for (int ct = 0; ct < 8; ++ct) {
            const bf16x8 vf = *(const LAS bf16x8*)(vnT + (16 * ct + fr) * VN_PITCH + 32 * ks + 8 * fq);
            acc[ct] = __builtin_amdgcn_mfma_f32_16x16x32_bf16(vf, wf, acc[ct], 0, 0, 0);
        }
    }
    const float bias = b_s[g * 128 + t];
    const size_t row = row0 + t;
#pragma unroll
    for (int ct = 0; ct < 8; ++ct) {
        const f32x4 gu = unpack4(*(const u32x2*)(GU + row * 512 + g * 128 + 16 * ct + 4 * fq));
        *(u32x2*)(AB + row * DM + 512 + g * 128 + 16 * ct + 4 * fq) = pack4(gu * (acc[ct] + bias));
    }
    __syncthreads();
}

__device__ __forceinline__ void sample_mixer(LAS unsigned char* lds, int b, const Args& a, const bf16_t* Q, const bf16_t* GU, const bf16_t* GV, bf16_t* AB) {
    const int tid = threadIdx.x, wid = __builtin_amdgcn_readfirstlane(tid >> 6), lane = tid & 63;
    LAS float* qs = (LAS float*)lds;
    LAS float* pw = (LAS float*)(lds + 2048) + wid * 136;
    LAS float* rs = (LAS float*)(lds + 2048 + 8 * 136 * 4);
    const size_t row = (size_t)MP + b;
    qs[tid] = bf2f(Q[row * 512 + tid]);
    const float gv = bf2f(GV[row * 512 + tid]);
    {
        float su = gv, sq = gv * gv;
#pragma unroll
        for (int o = 1; o < 64; o <<= 1) { su += __shfl_xor(su, o); sq += __shfl_xor(sq, o); }
        if (lane == 0) { rs[wid] = su; rs[8 + wid] = sq; }
    }
    __syncthreads();
    {
        float su = 0.f, sq = 0.f;
#pragma unroll
        for (int w = 0; w < 8; ++w) { su += rs[w]; sq += rs[8 + w]; }
        const float mean = su * (1.0f / 512.0f), var = fmaxf(sq * (1.0f / 512.0f) - mean * mean, 0.f), rstd = __builtin_amdgcn_rsqf(var + LN_EPS);
        const float vn = (gv - mean) * rstd * a.in[14][tid] + a.in[15][tid];
        a.out[O_GVS + (size_t)b * 512 + tid] = vn;
        const int g = tid >> 7;
        const float mix = a.in[16][(size_t)g * 128 * 128] * vn + a.in[17][g * 128];
        const float o = bf2f(GU[row * 512 + tid]) * mix;
        AB[row * DM + 512 + tid] = (bf16_t)(pg8::cvt_pk_bf16(o, 0.f) & 0xffffu);
    }
    {
        const int hq = wid, kvh = hq >> 2;
        const f32x4* k0 = (const f32x4*)(a.in[2] + ((size_t)(b * 128 + lane) * 2 + kvh) * 64);
        const f32x4* k1 = (const f32x4*)(a.in[2] + ((size_t)(b * 128 + lane + 64) * 2 + kvh) * 64);
        const f32x4* kn = (const f32x4*)(a.out + O_KWS + ((size_t)(b * 128 + 127) * 2 + kvh) * 64);
        const LAS f32x4* q4 = (const LAS f32x4*)(qs + hq * 64);
        float s0 = 0.f, s1 = 0.f, s2 = 0.f;
#pragma unroll 4
        for (int d = 0; d < 16; ++d) { const f32x4 qv = q4[d]; s0 += dot4(qv, k0[d]); s1 += dot4(qv, k1[d]); s2 += dot4(qv, kn[d]); }
        const float sink = a.in[13][hq];
        float mx = fmaxf(fmaxf(s0, s1), s2);
#pragma unroll
        for (int o = 1; o < 64; o <<= 1) mx = fmaxf(mx, __shfl_xor(mx, o));
        mx = fmaxf(mx, sink);
        const float e0 = fast_exp(s0 - mx), e1 = fast_exp(s1 - mx), e2 = fast_exp(s2 - mx);
        float sum = e0 + e1;
#pragma unroll
        for (int o = 1; o < 64; o <<= 1) sum += __shfl_xor(sum, o);
        sum += e2 + fast_exp(sink - mx);
        pw[lane] = e0; pw[64 + lane] = e1; if (lane == 0) pw[128] = e2;
        asm volatile("s_waitcnt lgkmcnt(0)" ::: "memory");
        const float* vb = a.in[3] + ((size_t)(b * 128) * 2 + kvh) * 64 + lane;
        float o = 0.f;
#pragma unroll 8
        for (int c = 0; c < 128; ++c) o += pw[c] * vb[(size_t)c * 128];
        o += pw[128] * a.out[O_VWS + ((size_t)(b * 128 + 127) * 2 + kvh) * 64 + lane];
        o *= 1.0f / sum;
        AB[row * DM + hq * 64 + lane] = (bf16_t)(pg8::cvt_pk_bf16(o, 0.f) & 0xffffu);
    }
    __syncthreads();
}

template <bool COOP>
__global__ void __launch_bounds__(512, 2) mk_fwd(Args a) {
    extern __shared__ __attribute__((aligned(16))) unsigned char lds_raw[];
    LAS unsigned char* lds = (LAS unsigned char*)lds_raw;
    const int tid = threadIdx.x, wid = __builtin_amdgcn_readfirstlane(tid >> 6), lane = tid & 63;
    const int G = gridDim.x, bx = blockIdx.x;
    unsigned char* ws = a.ws;
    bf16_t* W13A = (bf16_t*)(ws + WS_W13A); bf16_t* W2A = (bf16_t*)(ws + WS_W2A); bf16_t* W13B = (bf16_t*)(ws + WS_W13B); bf16_t* W2B = (bf16_t*)(ws + WS_W2B);
    bf16_t* WIN = (bf16_t*)(ws + WS_WIN); bf16_t* WOUT = (bf16_t*)(ws + WS_WOUT); bf16_t* WG = (bf16_t*)(ws + WS_WG); bf16_t* WP = (bf16_t*)(ws + WS_WP);
    bf16_t* XB = (bf16_t*)(ws + WS_XB); bf16_t* PB = (bf16_t*)(ws + WS_PB); bf16_t* PP = (bf16_t*)(ws + WS_PP);
    float* SS = (float*)(ws + WS_SS); float* LNP = (float*)(ws + WS_LNP);
    bf16_t* H = (bf16_t*)(ws + WS_H); bf16_t* Qb = (bf16_t*)(ws + WS_Q); bf16_t* Kb = (bf16_t*)(ws + WS_K); bf16_t* Vb = (bf16_t*)(ws + WS_V);
    bf16_t* GU = (bf16_t*)(ws + WS_GU); bf16_t* GV = (bf16_t*)(ws + WS_GV); bf16_t* AB = (bf16_t*)(ws + WS_AB);
    float* X = a.out;
    const int lo = a.ph_lo, hi = a.ph_hi;
#define IN(k) (lo <= (k) && (k) < hi)
#define SEAM(k) do { if constexpr (COOP) { if (IN(k) && IN((k) + 1)) cg::this_grid().sync(); } } while (0)

    if (IN(0)) p0_prologue(a, lds, wid, lane);
    SEAM(0);
    if (IN(1)) {
        pg8::Gemm g{XB, W13A, MP, 2 * FF, DM}; pg8::StaticOrder S; S.init(MP, 2 * FF, G, bx);
        EpiMain<QSwiglu> E{QSwiglu{H}, SS};
        pg8::gemm_phase<EpiMain<QSwiglu>, pg8::StaticOrder, true, true>(lds, g, S, E);
        skinny_gemm<QSwiglu>(lds, XB + (size_t)MP * DM, W13A, FF, DM, E.q, bx, G);
    }
    SEAM(1);
    if (IN(2)) {
        pg8::Gemm g{H, W2A, MP, DM, FF}; pg8::StaticOrder S; S.init(MP, DM, G, bx);
        EpiMain<QResid> E{QResid{a.in[0], a.in[1], X, XB, nullptr, SS, 0.5f}, nullptr};
        pg8::gemm_phase<EpiMain<QResid>, pg8::StaticOrder, true, true>(lds, g, S, E);
        skinny_gemm<QResid>(lds, H + (size_t)MP * FF, W2A, DM, FF, E.q, bx, G);
    }
    SEAM(2);
    if (IN(3)) {
        {
            pg8::Gemm g{XB, WIN, MP, NIN, DM}; pg8::StaticOrder S; S.init(MP, NIN, G, bx);
            EpiMain<QWin> E{QWin{a.in[12], Qb, Kb, Vb, GU, GV, LNP, a.out}, SS};
            pg8::gemm_phase<EpiMain<QWin>, pg8::StaticOrder, true, true>(lds, g, S, E);
            skinny_gemm<QWin>(lds, XB + (size_t)MP * DM, WIN, NIN, DM, E.q, bx, G);
        }
        {
            int kp = PLE; asm volatile("" : "+s"(kp));
            pg8::Gemm g{PB, WP, MP, DM, kp}; UpperOrder S; S.init(MP, DM, G, bx);
            EpiMain<QProj> E{QProj{PP}, nullptr};
            pg8::gemm_phase<EpiMain<QProj>, UpperOrder, true, true>(lds, g, S, E);
            skinny_gemm<QProj>(lds, PB + (size_t)MP * PLE, WP, DM, PLE, E.q, bx, G);
        }
    }
    SEAM(3);
    if (IN(4)) {
        for (int u = bx; u < NBATCH * 2 * 32; u += G) { const int n = u & 31, h = (u >> 5) & 1, b = u >> 6; attn_unit(lds, b, h, n, Qb, Kb, Vb, AB, a.in[13]); }
        for (int u = bx; u < NBATCH * 32 * 4; u += G) { const int g = u & 3, n = (u >> 2) & 31, b = u >> 7; gmlp_unit(lds, b, n, g, GU, GV, LNP, AB, a.in[14], a.in[15], a.in[16], a.in[17], a.out); }
        for (int u = bx; u < MS; u += G) sample_mixer(lds, u, a, Qb, GU, GV, AB);
    }
    SEAM(4);
    if (IN(5)) {
        pg8::Gemm g{AB, WOUT, MP, DM, DM}; pg8::StaticOrder S; S.init(MP, DM, G, bx);
        EpiMain<QResid> E{QResid{X, X + (size_t)MP * DM, X, XB, a.in[19], SS, 1.0f}, nullptr};
        pg8::gemm_phase<EpiMain<QResid>, pg8::StaticOrder, true, true>(lds, g, S, E);
        skinny_gemm<QResid>(lds, AB + (size_t)MP * DM, WOUT, DM, DM, E.q, bx, G);
    }
    SEAM(5);
    if (IN(6)) {
        pg8::Gemm g{XB, W13B, MP, 2 * FF, DM}; pg8::StaticOrder S; S.init(MP, 2 * FF, G, bx);
        EpiMain<QSwiglu> E{QSwiglu{H}, SS};
        pg8::gemm_phase<EpiMain<QSwiglu>, pg8::StaticOrder, true, true>(lds, g, S, E);
        skinny_gemm<QSwiglu>(lds, XB + (size_t)MP * DM, W13B, FF, DM, E.q, bx, G);
    }
    SEAM(6);
    if (IN(7)) {
        pg8::Gemm g{H, W2B, MP, DM, FF}; pg8::StaticOrder S; S.init(MP, DM, G, bx);
        EpiMain<QResid> E{QResid{X, X + (size_t)MP * DM, X, XB, nullptr, SS, 0.5f}, nullptr};
        pg8::gemm_phase<EpiMain<QResid>, pg8::StaticOrder, true, true>(lds, g, S, E);
        skinny_gemm<QResid>(lds, H + (size_t)MP * FF, W2B, DM, FF, E.q, bx, G);
    }
    SEAM(7);
    if (IN(8)) {
        pg8::Gemm g{XB, WG, MP, DM, DM}; pg8::StaticOrder S; S.init(MP, DM, G, bx);
        EpiMain<QGate> E{QGate{X, PP}, SS};
        pg8::gemm_phase<EpiMain<QGate>, pg8::StaticOrder, true, true>(lds, g, S, E);
        skinny_gemm<QGate>(lds, XB + (size_t)MP * DM, WG, DM, DM, E.q, bx, G);
    }
    SEAM(8);
    if (IN(9)) {
        const int gw = bx * 8 + wid, NGW = G * 8;
        const float* gf = a.in[27];
        f32x4 gg[4];
#pragma unroll
        for (int j = 0; j < 4; ++j) gg[j] = ((const f32x4*)gf)[lane + 64 * j];
        for (int m = gw; m < MT; m += NGW) {
            f32x4* xr = (f32x4*)(X + (size_t)m * DM);
            f32x4 v[4]; float s = 0.f;
#pragma unroll
            for (int j = 0; j < 4; ++j) { v[j] = xr[lane + 64 * j]; s += dot4(v[j], v[j]); }
#pragma unroll
            for (int o = 1; o < 64; o <<= 1) s += __shfl_xor(s, o);
            const float r = __builtin_amdgcn_rsqf(s * (1.0f / DM) + RMS_EPS);
#pragma unroll
            for (int j = 0; j < 4; ++j) xr[lane + 64 * j] = v[j] * r * gg[j];
        }
    }
#undef IN
#undef SEAM
}

extern "C" void kernel_launch(void* const* d_in, const int* in_sizes, int n_in, void* d_out, int out_size, void* d_ws, size_t ws_size, hipStream_t stream) {
    static int grid = 0;
    constexpr bool COOP = (MK_COOP != 0);
    const void* fn = (const void*)mk_fwd<COOP>;
    if (grid == 0) {
        if (n_in != 28 || (size_t)out_size != O_END || ws_size < WS_END) { fprintf(stderr, "kernel_launch: unexpected shapes (n_in %d out %d ws %zu, need %zu)\n", n_in, out_size, ws_size, (size_t)WS_END); grid = -1; return; }
        int dev = 0, cus = 0, per_cu = 0;
        (void)hipGetDevice(&dev);
        (void)hipDeviceGetAttribute(&cus, hipDeviceAttributeMultiprocessorCount, dev);
        if (hipFuncSetAttribute(fn, hipFuncAttributeMaxDynamicSharedMemorySize, LDS_BYTES) != hipSuccess) { fprintf(stderr, "kernel_launch: hipFuncSetAttribute failed\n"); grid = -1; return; }
        if (hipOccupancyMaxActiveBlocksPerMultiprocessor(&per_cu, fn, 512, LDS_BYTES) != hipSuccess || per_cu < 1) { fprintf(stderr, "kernel_launch: occupancy query says %d\n", per_cu); per_cu = 1; }
        (void)hipGetLastError();
        grid = cus;
    }
    if (grid < 0) return;
    Args a{};
    for (int i = 0; i < 28; ++i) a.in[i] = (const float*)d_in[i];
    a.out = (float*)d_out; a.ws = (unsigned char*)d_ws;
    if (COOP) {
        a.ph_lo = 0; a.ph_hi = NPHASE;
        void* args[] = {&a};
        hipError_t e = hipLaunchCooperativeKernel(fn, dim3(grid), dim3(512), args, LDS_BYTES, stream);
        if (e != hipSuccess) fprintf(stderr, "cooperative launch failed: %s (grid %d)\n", hipGetErrorString(e), grid);
    } else {
        for (int p = 0; p < NPHASE; ++p) { a.ph_lo = p; a.ph_hi = p + 1; hipLaunchKernelGGL(mk_fwd<COOP>, dim3(grid), dim3(512), LDS_BYTES, stream, a); }
    }
}
```

```cpp
#include <hip/hip_runtime.h>
#include <hip/hip_cooperative_groups.h>
#include <cstdio>
#include <cstdint>
namespace cg = cooperative_groups;
namespace pg8 {
#define PG8_LAS __attribute__((address_space(3)))
typedef unsigned short bf16_t;
typedef short bf16x8 __attribute__((ext_vector_type(8)));
typedef float f32x4 __attribute__((ext_vector_type(4)));
typedef unsigned u32x4 __attribute__((ext_vector_type(4)));
constexpr int BM = 256, BK = 64, HALF = 128, HTB = HALF * BK * 2  , STAGE_BYTES = 8 * HTB, NXCD = 8, WGM = 8;

__host__ __device__ __forceinline__ int lds_byte(int r, int c) { const int st = (r >> 4) * 2 + (c >> 5), rr = r & 15, cc = c & 31, ob = rr * 64 + cc * 2; return st * 1024 + (ob ^ (((ob >> 9) & 1) << 5)); }
__host__ __device__ __forceinline__ void stage_rc(int b, int& R, int& C) { const int st = b / 1024, sb = b % 1024, swz = sb ^ (((sb >> 9) & 1) << 5); R = (st >> 1) * 16 + swz / 64; C = (st & 1) * 32 + (swz % 64) / 2; }
__host__ __device__ __forceinline__ int perm32(int rho) { const int n = rho >> 4, i = rho & 15; return 8 * (i >> 2) + 4 * n + (i & 3); }

struct Unit { int pm, pn; };
struct Gemm { const bf16_t* A; const bf16_t* Bt; int M, N, K; };

struct StaticOrder {
    int nM, nN, nwg, G, c;
    __host__ __device__ void init(int M, int N, int G_, int c_) { nM = M / BM; nN = N / BM; nwg = nM * nN; G = G_; c = c_; }
    __host__ __device__ bool next(int i, Unit& u) const {
        const long L = (long)i * G + c; if (L >= nwg) return false;
        int wgid = (int)L; { const int q = nwg / NXCD, r = nwg % NXCD, xcd = wgid % NXCD, off = wgid / NXCD; wgid = (xcd < r ? xcd * (q + 1) : r * (q + 1) + (xcd - r) * q) + off; }
        const int nig = WGM * nN, gid = wgid / nig, fm = gid * WGM, gsz = (nM - fm) < WGM ? (nM - fm) : WGM;
        u.pm = fm + ((wgid % nig) % gsz); u.pn = (wgid % nig) / gsz; return true;
    }
    __device__ __forceinline__ void a_ready(const Unit&) const {}
    __device__ __forceinline__ void done(const Unit&) const {}
};

__device__ __forceinline__ unsigned cvt_pk_bf16(float lo, float hi) { unsigned r; asm volatile("v_cvt_pk_bf16_f32 %0, %1, %2" : "=v"(r) : "v"(lo), "v"(hi)); return r; }
typedef float f32x2 __attribute__((ext_vector_type(2)));
template <class Epi, class Sched, bool ALIGN_EPI = false, bool SP2 = false>
__device__ __forceinline__ void gemm_phase(PG8_LAS unsigned char* lds, const Gemm g, const Sched& S, const Epi& E) {
    const int tid = threadIdx.x, wid = __builtin_amdgcn_readfirstlane(tid >> 6), lane = tid & 63, wr = wid >> 2, wc = wid & 3, fr = lane & 15, fq = lane >> 4;
    const int K = g.K, nt = K / BK;
    unsigned voffA[2], voffB[2];
#pragma unroll
    for (int i = 0; i < 2; ++i) { int R, C; stage_rc(tid * 16 + i * 8192, R, C); const int Rb = Epi::PERM ? ((R & ~31) + perm32(R & 31)) : R;
        voffA[i] = (unsigned)(R * K + C) * 2u; voffB[i] = (unsigned)(Rb * K + C) * 2u; }
    const size_t kstep = (size_t)(BK * 2);
    const size_t hstep = (size_t)HALF * K * 2;
    const size_t tstep = 2 * hstep;
    const unsigned ldsw = (unsigned)wid * 1024u;
    const int aoff = lds_byte(wr * 64 + fr, fq * 8), boff = lds_byte(wc * 32 + fr, fq * 8);
#define PG8_SA(b, h) (((b) * 2 + (h)) * HTB)
#define PG8_SB(b, h) ((4 + (b) * 2 + (h)) * HTB)
#define PG8_STAGE(bufoff, gbase, voff) do { _Pragma("unroll") for (int _i = 0; _i < 2; ++_i) \
        __builtin_amdgcn_global_load_lds((const unsigned*)((const char*)(gbase) + (voff)[_i]), (PG8_LAS unsigned*)(lds + (bufoff) + ldsw + _i * 8192), 16, 0, 0); } while (0)
#define PG8_LDA(dst, b, h) do { _Pragma("unroll") for (int m = 0; m < 4; ++m) _Pragma("unroll") for (int k = 0; k < 2; ++k) dst[m][k] = *(const PG8_LAS bf16x8*)(lds + PG8_SA(b, h) + aoff + m * 2048 + k * 1024); } while (0)
#define PG8_LDB(dst, b, h) do { _Pragma("unroll") for (int n = 0; n < 2; ++n) _Pragma("unroll") for (int k = 0; k < 2; ++k) dst[n][k] = *(const PG8_LAS bf16x8*)(lds + PG8_SB(b, h) + boff + n * 2048 + k * 1024); } while (0)
#define PG8_MMA(ai, bj, At, Bt) do { __builtin_amdgcn_s_setprio(1); _Pragma("unroll") for (int m = 0; m < 4; ++m) _Pragma("unroll") for (int n = 0; n < 2; ++n) _Pragma("unroll") for (int k = 0; k < 2; ++k) \
        acc[ai][bj][m][n] = __builtin_amdgcn_mfma_f32_16x16x32_bf16(Bt[n][k], At[m][k], acc[ai][bj][m][n], 0, 0, 0); __builtin_amdgcn_s_setprio(0); } while (0)
#define PG8_WAIT_V(n) asm volatile("s_waitcnt vmcnt(" #n ")" ::: "memory")
#define PG8_WAIT_L(n) asm volatile("s_waitcnt lgkmcnt(" #n ")" ::: "memory")
#define PG8_BAR __builtin_amdgcn_s_barrier()
#define PG8_SCHED __builtin_amdgcn_sched_barrier(0)
    Unit cur, nxt; int ui = 0;
    if (!S.next(0, cur)) return;
    f32x4 acc[2][2][4][2];
#pragma unroll
    for (int a = 0; a < 2; ++a)
#pragma unroll
        for (int b = 0; b < 2; ++b)
#pragma unroll
            for (int m = 0; m < 4; ++m)
#pragma unroll
                for (int n = 0; n < 2; ++n) acc[a][b][m][n] = (f32x4){0.f, 0.f, 0.f, 0.f};
    bf16x8 At[4][2], B0[2][2], B1[2][2];
    const char* cA = (const char*)g.A + (size_t)cur.pm * tstep; const char* cB = (const char*)g.Bt + (size_t)cur.pn * tstep;
    S.a_ready(cur);
    if constexpr (SP2) {
        PG8_STAGE(PG8_SB(0, 0), cB, voffB); PG8_STAGE(PG8_SB(0, 1), cB + hstep, voffB); PG8_STAGE(PG8_SA(0, 0), cA, voffA); PG8_STAGE(PG8_SA(0, 1), cA + hstep, voffA);
        if (wr == 1) PG8_BAR;
        PG8_WAIT_V(2); PG8_BAR;
        PG8_STAGE(PG8_SB(1, 0), cB + kstep, voffB); PG8_STAGE(PG8_SA(1, 0), cA + kstep, voffA); PG8_STAGE(PG8_SB(1, 1), cB + hstep + kstep, voffB);
        PG8_WAIT_V(6); PG8_BAR;
    } else {
        PG8_STAGE(PG8_SB(0, 0), cB, voffB); PG8_STAGE(PG8_SA(0, 0), cA, voffA); PG8_STAGE(PG8_SB(0, 1), cB + hstep, voffB); PG8_STAGE(PG8_SA(0, 1), cA + hstep, voffA);
        if (wr == 1) PG8_BAR;
        PG8_WAIT_V(4); PG8_BAR;
        PG8_STAGE(PG8_SB(1, 0), cB + kstep, voffB); PG8_STAGE(PG8_SA(1, 0), cA + kstep, voffA); PG8_STAGE(PG8_SB(1, 1), cB + hstep + kstep, voffB);
        PG8_WAIT_V(6); PG8_BAR;
    }
    for (;;) {
        const bool has_next = S.next(ui + 1, nxt);
        const char* nA = has_next ? (const char*)g.A + (size_t)nxt.pm * tstep : cA; const char* nB = has_next ? (const char*)g.Bt + (size_t)nxt.pn * tstep : cB;
        for (int t = 0; t < nt; t += 2) {
            const bool last = (t == nt - 2);
            const char* a1 = cA + (size_t)(t + 1) * kstep;
            const char* a2 = last ? nA : cA + (size_t)(t + 2) * kstep; const char* b2 = last ? nB : cB + (size_t)(t + 2) * kstep;
            const char* a3 = a2 + kstep; const char* b3 = b2 + kstep;
            if (last && has_next) S.a_ready(nxt);
            if constexpr (SP2) {
            PG8_LDB(B0, 0, 0); PG8_LDB(B1, 0, 1); PG8_SCHED; PG8_LDA(At, 0, 0); PG8_STAGE(PG8_SA(1, 1), a1 + hstep, voffA);
            PG8_WAIT_V(8); PG8_WAIT_L(0); PG8_BAR; PG8_MMA(0, 0, At, B0); PG8_MMA(0, 1, At, B1); PG8_BAR; PG8_SCHED;
            PG8_LDA(At, 0, 1); PG8_STAGE(PG8_SB(0, 0), b2, voffB); PG8_STAGE(PG8_SB(0, 1), b2 + hstep, voffB); PG8_STAGE(PG8_SA(0, 0), a2, voffA);
            PG8_WAIT_V(8); PG8_WAIT_L(0); PG8_BAR; PG8_MMA(1, 0, At, B0); PG8_MMA(1, 1, At, B1); PG8_BAR; PG8_SCHED;
            PG8_LDB(B0, 1, 0); PG8_LDB(B1, 1, 1); PG8_SCHED; PG8_LDA(At, 1, 0); PG8_STAGE(PG8_SA(0, 1), a2 + hstep, voffA);
            PG8_WAIT_V(8); PG8_WAIT_L(0); PG8_BAR; PG8_MMA(0, 0, At, B0); PG8_MMA(0, 1, At, B1); PG8_BAR; PG8_SCHED;
            PG8_LDA(At, 1, 1); PG8_STAGE(PG8_SB(1, 0), b3, voffB); PG8_STAGE(PG8_SB(1, 1), b3 + hstep, voffB); PG8_STAGE(PG8_SA(1, 0), a3, voffA);
            PG8_WAIT_V(8); PG8_WAIT_L(0); PG8_BAR; PG8_MMA(1, 0, At, B0); PG8_MMA(1, 1, At, B1); PG8_BAR; PG8_SCHED;
            } else {
            PG8_LDB(B0, 0, 0); PG8_SCHED; PG8_LDA(At, 0, 0); PG8_STAGE(PG8_SA(1, 1), a1 + hstep, voffA);
            PG8_WAIT_L(8); PG8_BAR; PG8_WAIT_L(0); PG8_MMA(0, 0, At, B0); PG8_BAR; PG8_SCHED;
            PG8_LDB(B1, 0, 1); PG8_STAGE(PG8_SB(0, 0), b2, voffB);
            PG8_BAR; PG8_WAIT_L(0); PG8_MMA(0, 1, At, B1); PG8_BAR;
            PG8_LDA(At, 0, 1); PG8_STAGE(PG8_SA(0, 0), a2, voffA);
            PG8_BAR; PG8_WAIT_L(0); PG8_MMA(1, 0, At, B0); PG8_BAR; PG8_SCHED;
            PG8_STAGE(PG8_SB(0, 1), b2 + hstep, voffB);
            PG8_WAIT_V(6); PG8_BAR; PG8_MMA(1, 1, At, B1); PG8_BAR;
            PG8_LDB(B0, 1, 0); PG8_SCHED; PG8_LDA(At, 1, 0); PG8_STAGE(PG8_SA(0, 1), a2 + hstep, voffA);
            PG8_WAIT_L(8); PG8_BAR; PG8_WAIT_L(0); PG8_MMA(0, 0, At, B0); PG8_BAR; PG8_SCHED;
            PG8_LDB(B1, 1, 1); PG8_STAGE(PG8_SB(1, 0), b3, voffB);
            PG8_BAR; PG8_WAIT_L(0); PG8_MMA(0, 1, At, B1); PG8_BAR;
            PG8_LDA(At, 1, 1); PG8_STAGE(PG8_SA(1, 0), a3, voffA);
            PG8_BAR; PG8_WAIT_L(0); PG8_MMA(1, 0, At, B0); PG8_BAR; PG8_SCHED;
            PG8_STAGE(PG8_SB(1, 1), b3 + hstep, voffB);
            PG8_WAIT_V(6); PG8_BAR; PG8_MMA(1, 1, At, B1); PG8_BAR;
            }
        }
        if constexpr (ALIGN_EPI) { if (wr == 0) PG8_BAR; }
        if constexpr (!Epi::AFTER_DRAIN) { E(acc, cur, wr, wc, fr, fq); S.done(cur); }
        if (!has_next) break;
#pragma unroll
        for (int a = 0; a < 2; ++a)
#pragma unroll
            for (int b = 0; b < 2; ++b)
#pragma unroll
                for (int m = 0; m < 4; ++m)
#pragma unroll
                    for (int n = 0; n < 2; ++n) acc[a][b][m][n] = (f32x4){0.f, 0.f, 0.f, 0.f};
        cur = nxt; cA = nA; cB = nB; ++ui;
        if constexpr (ALIGN_EPI) { if (wr == 1) PG8_BAR; }
    }
    PG8_WAIT_V(0);
    if constexpr (!ALIGN_EPI) { if (wr == 0) PG8_BAR; }
    PG8_BAR;
    if constexpr (Epi::AFTER_DRAIN) { E.fused(acc, cur, wr, wc, fr, fq, lds, wid, lane); S.done(cur); }
#undef PG8_SA
#undef PG8_SB
#undef PG8_STAGE
#undef PG8_LDA
#undef PG8_LDB
#undef PG8_MMA
#undef PG8_WAIT_V
#undef PG8_WAIT_L
#undef PG8_BAR
#undef PG8_SCHED
}
}

#ifndef MK_COOP
#define MK_COOP 1
#endif

#define LAS __attribute__((address_space(3)))
typedef pg8::f32x4 f32x4;
typedef pg8::bf16_t bf16_t;
typedef pg8::bf16x8 bf16x8;
typedef unsigned u32x2 __attribute__((ext_vector_type(2)));
typedef unsigned u32x4 __attribute__((ext_vector_type(4)));

constexpr int DM = 1024, SEQ = 4096, NBATCH = 8, MP = NBATCH * SEQ, MS = 128, MT = MP + MS;
constexpr int FF = 2816, NIN = 1792, PLE = 256;
constexpr float RMS_EPS = 1e-6f, LN_EPS = 1e-5f;
constexpr int NPHASE = 10;

constexpr size_t O_Y = 0, O_KWP = (size_t)MT * DM, O_VWP = O_KWP + 131072, O_KWS = O_VWP + 131072, O_VWS = O_KWS + 2097152,
                 O_GVP = O_VWS + 2097152, O_GVS = O_GVP + 524288, O_END = O_GVS + 65536;

constexpr size_t al256(size_t x) { return (x + 255) & ~(size_t)255; }
constexpr size_t WS_W13A = 0;
constexpr size_t WS_W2A = al256(WS_W13A + (size_t)2 * FF * DM * 2);
constexpr size_t WS_W13B = al256(WS_W2A + (size_t)DM * FF * 2);
constexpr size_t WS_W2B = al256(WS_W13B + (size_t)2 * FF * DM * 2);
constexpr size_t WS_WIN = al256(WS_W2B + (size_t)DM * FF * 2);
constexpr size_t WS_WOUT = al256(WS_WIN + (size_t)NIN * DM * 2);
constexpr size_t WS_WG = al256(WS_WOUT + (size_t)DM * DM * 2);
constexpr size_t WS_WP = al256(WS_WG + (size_t)DM * DM * 2);
constexpr size_t WS_XB = al256(WS_WP + (size_t)DM * PLE * 2);
constexpr size_t WS_PB = al256(WS_XB + (size_t)MT * DM * 2);
constexpr size_t WS_PP = al256(WS_PB + (size_t)MT * PLE * 2);
constexpr size_t WS_SS = al256(WS_PP + (size_t)MT * DM * 2);
constexpr size_t WS_LNP = al256(WS_SS + (size_t)MT * 16 * 4);
constexpr size_t WS_H = al256(WS_LNP + (size_t)MT * 16 * 4);
constexpr size_t WS_Q = WS_H;
constexpr size_t WS_K = WS_Q + (size_t)MT * 512 * 2;
constexpr size_t WS_V = WS_K + (size_t)MT * 128 * 2;
constexpr size_t WS_GU = WS_V + (size_t)MT * 128 * 2;
constexpr size_t WS_GV = WS_GU + (size_t)MT * 512 * 2;
constexpr size_t WS_AB = WS_GV + (size_t)MT * 512 * 2;
constexpr size_t WS_END = al256(WS_H + (size_t)MT * FF * 2);
static_assert(WS_AB + (size_t)MT * DM * 2 <= WS_END, "overlay fits in h");
constexpr size_t WS_CTL = WS_END, CTL_BYTES = 16384, WS_TOTAL = WS_CTL + CTL_BYTES;
constexpr int LDS_ST_OFF = 131072 + 1024;

constexpr int LDS_BYTES = 147456;

__device__ __forceinline__ float bf2f(unsigned short b) { return __uint_as_float((unsigned)b << 16); }
__device__ __forceinline__ float fast_exp(float x) { return __builtin_amdgcn_exp2f(x * 1.44269504089f); }
__device__ __forceinline__ float sigmoid_(float x) { return __builtin_amdgcn_rcpf(1.f + fast_exp(-x)); }
__device__ __forceinline__ float silu_(float x) { return x * sigmoid_(x); }
__device__ __forceinline__ float gelu_(float x) { return x * sigmoid_(1.5957691216f * (x + 0.044715f * x * x * x)); }
__device__ __forceinline__ u32x2 pack4(f32x4 v) { u32x2 w; w.x = pg8::cvt_pk_bf16(v[0], v[1]); w.y = pg8::cvt_pk_bf16(v[2], v[3]); return w; }
__device__ __forceinline__ f32x4 unpack4(u32x2 w) { return (f32x4){__uint_as_float(w.x << 16), __uint_as_float(w.x & 0xffff0000u), __uint_as_float(w.y << 16), __uint_as_float(w.y & 0xffff0000u)}; }
__device__ __forceinline__ float dot4(f32x4 a, f32x4 b) { return (a[0] * b[0] + a[1] * b[1]) + (a[2] * b[2] + a[3] * b[3]); }

struct QSwiglu {
    static constexpr bool NEED_R = true, SWI = true, STAT = false;
    bf16_t* H;
    __device__ __forceinline__ void quad2(int row, int col, float r, f32x4 a, f32x4 b) const {
        typedef float f32x2 __attribute__((ext_vector_type(2)));
        const float nr = r * -1.44269504089f, r2 = r * r;
        unsigned w[2];
#pragma unroll
        for (int h = 0; h < 2; ++h) {
            const f32x2 a2 = (f32x2){a[2 * h], a[2 * h + 1]}, b2 = (f32x2){b[2 * h], b[2 * h + 1]};
            const f32x2 t = a2 * nr;
            f32x2 e; e.x = __builtin_amdgcn_exp2f(t.x); e.y = __builtin_amdgcn_exp2f(t.y);
            const f32x2 d = e + 1.0f;
            f32x2 q; q.x = __builtin_amdgcn_rcpf(d.x); q.y = __builtin_amdgcn_rcpf(d.y);
            const f32x2 o = ((a2 * b2) * r2) * q;
            w[h] = pg8::cvt_pk_bf16(o.x, o.y);
        }
        *(u32x2*)(H + (size_t)row * FF + col) = (u32x2){w[0], w[1]};
    }
};
struct QResid {
    static constexpr bool NEED_R = false, SWI = false, STAT = true;
    bf16_t* XB; const float* bias; float* SS; float scale;
    __device__ __forceinline__ float quad(int row, int col, float r, f32x4 v, float& s1) const {
        s1 = 0.f;
        u32x2* p = (u32x2*)(XB + (size_t)row * DM + col);
        f32x4 o = unpack4(*p) + v * scale;
        if (bias) o = o + *(const f32x4*)(bias + col);
        *p = pack4(o);
        return dot4(o, o);
    }
    __device__ __forceinline__ void rowstat(int row, int pn, int wc, float s0, float s1) const { SS[(size_t)row * 16 + pn * 4 + wc] = s0; }
};
struct QWin {
    static constexpr bool NEED_R = true, SWI = false, STAT = true;
    const float* bias; bf16_t *Q, *K, *V, *GU, *GV; float* LNP; float* out;
    __device__ __forceinline__ float quad(int row, int col, float r, f32x4 v, float& s1) const {
        const f32x4 z = v * r + *(const f32x4*)(bias + col);
        s1 = 0.f;
        const int cb = __builtin_amdgcn_readfirstlane(col >> 7);
        if (cb < 4) { *(u32x2*)(Q + (size_t)row * 512 + col) = pack4(z * 0.125f); return 0.f; }
        if (cb < 6) {
            const bool isk = cb == 4; const int c = col - (isk ? 512 : 640);
            *(u32x2*)((isk ? K : V) + (size_t)row * 128 + c) = pack4(z);
            if (row >= MP) { *(f32x4*)(out + (isk ? O_KWS : O_VWS) + ((size_t)(row - MP) * 128 + 127) * 128 + c) = z; }
            else { const int t = row & (SEQ - 1); if (t >= SEQ - 128) *(f32x4*)(out + (isk ? O_KWP : O_VWP) + ((size_t)(row >> 12) * 128 + (t - (SEQ - 128))) * 128 + c) = z; }
            return 0.f;
        }
        f32x4 g;
#pragma unroll
        for (int i = 0; i < 4; ++i) g[i] = gelu_(z[i]);
        if (cb < 10) { *(u32x2*)(GU + (size_t)row * 512 + (col - 768)) = pack4(g); return 0.f; }
        *(u32x2*)(GV + (size_t)row * 512 + (col - 1280)) = pack4(g);
        s1 = dot4(g, g);
        return (g[0] + g[1]) + (g[2] + g[3]);
    }
    __device__ __forceinline__ void rowstat(int row, int pn, int wc, float s0, float s1) const {
        if (pn >= 5) { float* p = LNP + (size_t)row * 16 + ((pn - 5) * 4 + wc) * 2; p[0] = s0; p[1] = s1; }
    }
};
struct QProj {
    static constexpr bool NEED_R = false, SWI = false, STAT = false;
    bf16_t* PP;
    __device__ __forceinline__ float quad(int row, int col, float r, f32x4 v, float& s1) const { s1 = 0.f; *(u32x2*)(PP + (size_t)row * DM + col) = pack4(v); return 0.f; }
};
struct QGate {
    static constexpr bool NEED_R = true, SWI = false, STAT = false;
    bf16_t* X; const bf16_t* XB; const bf16_t* PP;
    __device__ __forceinline__ float quad(int row, int col, float r, f32x4 v, float& s1) const {
        s1 = 0.f;
        const f32x4 pp = unpack4(*(const u32x2*)(PP + (size_t)row * DM + col));
        f32x4 x = unpack4(*(const u32x2*)(XB + (size_t)row * DM + col));
#pragma unroll
        for (int i = 0; i < 4; ++i) x[i] += sigmoid_(v[i] * r) * pp[i];
        *(u32x2*)(X + (size_t)row * DM + col) = pack4(x);
        return 0.f;
    }
};

template <class Q> struct EpiMain {
    static constexpr bool PERM = false, AFTER_DRAIN = false;
    Q q; const float* ss;
    __device__ __forceinline__ void operator()(const f32x4 (&acc)[2][2][4][2], const pg8::Unit& u, int wr, int wc, int fr, int fq) const {
        float rr[2][4];
        if constexpr (Q::NEED_R) {
            f32x4 p[2][4];
#pragma unroll
            for (int ai = 0; ai < 2; ++ai)
#pragma unroll
                for (int m = 0; m < 4; ++m) p[ai][m] = *(const f32x4*)(ss + (size_t)(u.pm * 256 + ai * 128 + wr * 64 + m * 16 + fr) * 16 + 4 * fq);
#pragma unroll
            for (int ai = 0; ai < 2; ++ai)
#pragma unroll
                for (int m = 0; m < 4; ++m) {
                    float s = (p[ai][m][0] + p[ai][m][1]) + (p[ai][m][2] + p[ai][m][3]); s += __shfl_xor(s, 16); s += __shfl_xor(s, 32);
                    rr[ai][m] = __builtin_amdgcn_rsqf(s * (1.0f / DM) + RMS_EPS);
                }
        }
#pragma unroll
        for (int ai = 0; ai < 2; ++ai) {
#pragma unroll
            for (int m = 0; m < 4; ++m) {
                const int row = u.pm * 256 + ai * 128 + wr * 64 + m * 16 + fr;
                float r = 1.f;
                if constexpr (Q::NEED_R) r = rr[ai][m];
                if constexpr (Q::SWI) {
#pragma unroll
                    for (int n = 0; n < 2; ++n) q.quad2(row, u.pn * 128 + wc * 32 + n * 16 + 4 * fq, r, acc[ai][0][m][n], acc[ai][1][m][n]);
                } else {
                    float s0 = 0.f, s1 = 0.f;
#pragma unroll
                    for (int bj = 0; bj < 2; ++bj)
#pragma unroll
                        for (int n = 0; n < 2; ++n) {
                            const int col = u.pn * 256 + bj * 128 + wc * 32 + n * 16 + 4 * fq;
                            float t1; s0 += q.quad(row, col, r, acc[ai][bj][m][n], t1); s1 += t1;
                        }
                    if constexpr (Q::STAT) {
                        s0 += __shfl_xor(s0, 16); s0 += __shfl_xor(s0, 32);
                        s1 += __shfl_xor(s1, 16); s1 += __shfl_xor(s1, 32);
                        if (fq == 0) q.rowstat(row, u.pn, wc, s0, s1);
                    }
                }
            }
            asm volatile("" ::: "memory");
        }
    }
};

struct UpperOrder {
    int nN, total, c, off, G2;
    __device__ void init(int M, int N, int G, int c_) { nN = N / 256; total = (M / 256) * nN; off = G / 2; G2 = G - off; c = c_; }
    __device__ bool next(int i, pg8::Unit& u) const { if (c < off) return false; const int L = i * G2 + (c - off); if (L >= total) return false; u.pm = L / nN; u.pn = L % nN; return true; }
    __device__ __forceinline__ void a_ready(const pg8::Unit&) const {}
    __device__ __forceinline__ void done(const pg8::Unit&) const {}
};

template <class Q>
__device__ __forceinline__ void skinny_gemm(LAS unsigned char* lds, const bf16_t* A, const bf16_t* Bt, int N, int K, const Q& q, int item0, int item_stride) {
    const int tid = threadIdx.x, wid = __builtin_amdgcn_readfirstlane(tid >> 6), lane = tid & 63, fr = lane & 15, fq = lane >> 4;
    LAS f32x4* red = (LAS f32x4*)lds;
    LAS float* redsq = (LAS float*)(lds + 65536);
    const int nitems = (N / 16) * 2, kw = K / 8, nsteps = kw / 32;
    for (int item = item0; item < nitems; item += item_stride) {
        const int nb = item >> 1, rh = item & 1;
        size_t brow0, brow1 = 0;
        if constexpr (Q::SWI) { const int hc = nb * 16 + fr; brow0 = (size_t)((hc >> 7) * 256 + (hc & 127)); brow1 = brow0 + 128; }
        else brow0 = (size_t)(nb * 16 + fr);
        f32x4 acc0[4], acc1[4]; float sq[4];
#pragma unroll
        for (int rt = 0; rt < 4; ++rt) { acc0[rt] = (f32x4){0.f, 0.f, 0.f, 0.f}; acc1[rt] = (f32x4){0.f, 0.f, 0.f, 0.f}; sq[rt] = 0.f; }
        const bf16_t* ap = A + (size_t)(rh * 64 + fr) * K + wid * kw + fq * 8;
        const bf16_t* bp0 = Bt + brow0 * K + wid * kw + fq * 8;
        const bf16_t* bp1 = Bt + brow1 * K + wid * kw + fq * 8;
        for (int s = 0; s < nsteps; ++s) {
            const bf16x8 b0 = *(const bf16x8*)(bp0 + s * 32);
            bf16x8 b1; if constexpr (Q::SWI) b1 = *(const bf16x8*)(bp1 + s * 32);
#pragma unroll
            for (int rt = 0; rt < 4; ++rt) {
                const bf16x8 a = *(const bf16x8*)(ap + (size_t)rt * 16 * K + s * 32);
                acc0[rt] = __builtin_amdgcn_mfma_f32_16x16x32_bf16(b0, a, acc0[rt], 0, 0, 0);
                if constexpr (Q::SWI) acc1[rt] = __builtin_amdgcn_mfma_f32_16x16x32_bf16(b1, a, acc1[rt], 0, 0, 0);
                if constexpr (Q::NEED_R) {
#pragma unroll
                    for (int e = 0; e < 8; ++e) { const float f = bf2f((unsigned short)a[e]); sq[rt] += f * f; }
                }
            }
        }
#pragma unroll
        for (int rt = 0; rt < 4; ++rt) {
            red[((wid * 2 + 0) * 4 + rt) * 64 + lane] = acc0[rt];
            if constexpr (Q::SWI) red[((wid * 2 + 1) * 4 + rt) * 64 + lane] = acc1[rt];
            if constexpr (Q::NEED_R) redsq[(wid * 4 + rt) * 64 + lane] = sq[rt];
        }
        __syncthreads();
        if (tid < 256) {
            const int rt = tid >> 6;
            f32x4 v0 = (f32x4){0.f, 0.f, 0.f, 0.f}, v1 = (f32x4){0.f, 0.f, 0.f, 0.f};
#pragma unroll
            for (int w = 0; w < 8; ++w) { v0 = v0 + red[((w * 2 + 0) * 4 + rt) * 64 + lane]; if constexpr (Q::SWI) v1 = v1 + red[((w * 2 + 1) * 4 + rt) * 64 + lane]; }
            float r = 1.f;
            if constexpr (Q::NEED_R) {
                float s = 0.f;
#pragma unroll
                for (int w = 0; w < 8; ++w)
#pragma unroll
                    for (int f = 0; f < 4; ++f) s += redsq[(w * 4 + rt) * 64 + f * 16 + fr];
                r = __builtin_amdgcn_rsqf(s * (1.0f / (float)K) + RMS_EPS);
            }
            const int row = MP + rh * 64 + rt * 16 + fr, col = nb * 16 + 4 * fq;
            if constexpr (Q::SWI) q.quad2(row, col, r, v0, v1); else { float t1; (void)q.quad(row, col, r, v0, t1); }
        }
        __syncthreads();
    }
}

__device__ __forceinline__ void p0_transpose_item(const float* W, int K, int N, const float* gk, bf16_t* WT, int mode, LAS float* scr, int item, int lane) {
    const int nblk = N / 32, kb = item / nblk, nb = item % nblk, k0 = 64 * kb, n0 = 32 * nb;
    float wv[32];
#pragma unroll
    for (int i = 0; i < 32; ++i) wv[i] = W[(size_t)(k0 + 2 * i + (lane >> 5)) * N + n0 + (lane & 31)];
    if (gk) {
#pragma unroll
        for (int i = 0; i < 32; ++i) wv[i] *= gk[k0 + 2 * i + (lane >> 5)];
    }
#pragma unroll
    for (int i = 0; i < 32; ++i) scr[(2 * i + (lane >> 5)) * 33 + (lane & 31)] = wv[i];
    asm volatile("s_waitcnt lgkmcnt(0)" ::: "memory");
    const int drow0 = mode == 0 ? n0 : ((n0 >> 7) * 256 + (n0 & 127) + (mode == 2 ? 128 : 0));
    const int c = lane & 7;
#pragma unroll
    for (int j = 0; j < 4; ++j) { const int n = (lane >> 3) + 8 * j; const LAS float* s = scr + (8 * c) * 33 + n;
        u32x4 o; o.x = pg8::cvt_pk_bf16(s[0 * 33], s[1 * 33]); o.y = pg8::cvt_pk_bf16(s[2 * 33], s[3 * 33]); o.z = pg8::cvt_pk_bf16(s[4 * 33], s[5 * 33]); o.w = pg8::cvt_pk_bf16(s[6 * 33], s[7 * 33]);
        *(u32x4*)(WT + (size_t)(drow0 + n) * K + k0 + 8 * c) = o; }
    asm volatile("s_waitcnt lgkmcnt(0)" ::: "memory");
}

struct Args { const float* in[28]; float* out; unsigned char* ws; int ph_lo, ph_hi; };

__device__ __forceinline__ void p0_prologue(const Args& a, LAS unsigned char* lds, int wid, int lane) {
    unsigned char* ws = a.ws;
    LAS float* scr = (LAS float*)(lds + wid * 16384);
    const int gw = blockIdx.x * 8 + wid, NGW = gridDim.x * 8;
    constexpr int I13 = (DM / 64) * (FF / 32), I2 = (FF / 64) * (DM / 32), IIN = (DM / 64) * (NIN / 32), ISQ = (DM / 64) * (DM / 32), IP = (PLE / 64) * (DM / 32);
    constexpr int NITEMS = 4 * I13 + 2 * I2 + IIN + 2 * ISQ + IP;
    for (int it = gw; it < NITEMS; it += NGW) {
        int r = it;
        if (r < I13) { p0_transpose_item(a.in[7], DM, FF, a.in[6], (bf16_t*)(ws + WS_W13A), 1, scr, r, lane); continue; } r -= I13;
        if (r < I13) { p0_transpose_item(a.in[8], DM, FF, a.in[6], (bf16_t*)(ws + WS_W13A), 2, scr, r, lane); continue; } r -= I13;
        if (r < I13) { p0_transpose_item(a.in[21], DM, FF, a.in[20], (bf16_t*)(ws + WS_W13B), 1, scr, r, lane); continue; } r -= I13;
        if (r < I13) { p0_transpose_item(a.in[22], DM, FF, a.in[20], (bf16_t*)(ws + WS_W13B), 2, scr, r, lane); continue; } r -= I13;
        if (r < I2) { p0_transpose_item(a.in[9], FF, DM, nullptr, (bf16_t*)(ws + WS_W2A), 0, scr, r, lane); continue; } r -= I2;
        if (r < I2) { p0_transpose_item(a.in[23], FF, DM, nullptr, (bf16_t*)(ws + WS_W2B), 0, scr, r, lane); continue; } r -= I2;
        if (r < IIN) { p0_transpose_item(a.in[11], DM, NIN, a.in[10], (bf16_t*)(ws + WS_WIN), 0, scr, r, lane); continue; } r -= IIN;
        if (r < ISQ) { p0_transpose_item(a.in[18], DM, DM, nullptr, (bf16_t*)(ws + WS_WOUT), 0, scr, r, lane); continue; } r -= ISQ;
        if (r < ISQ) { p0_transpose_item(a.in[25], DM, DM, a.in[24], (bf16_t*)(ws + WS_WG), 0, scr, r, lane); continue; } r -= ISQ;
        p0_transpose_item(a.in[26], PLE, DM, nullptr, (bf16_t*)(ws + WS_WP), 0, scr, r, lane);
    }
    bf16_t* XB = (bf16_t*)(ws + WS_XB); float* SS = (float*)(ws + WS_SS); bf16_t* PB = (bf16_t*)(ws + WS_PB);
    for (int m0 = gw; m0 < MT; m0 += 4 * NGW) {
        f32x4 v[4][4], pv[4];
#pragma unroll
        for (int q = 0; q < 4; ++q) {
            const int m = m0 + q * NGW;
            if (m < MT) {
                const float* xr = m < MP ? a.in[0] + (size_t)m * DM : a.in[1] + (size_t)(m - MP) * DM;
                const float* pr = m < MP ? a.in[4] + (size_t)m * PLE : a.in[5] + (size_t)(m - MP) * PLE;
#pragma unroll
                for (int j = 0; j < 4; ++j) v[q][j] = ((const f32x4*)xr)[lane + 64 * j];
                pv[q] = ((const f32x4*)pr)[lane];
            }
        }
#pragma unroll
        for (int q = 0; q < 4; ++q) {
            const int m = m0 + q * NGW;
            if (m < MT) {
#pragma unroll
                for (int j = 0; j < 4; ++j) {
                    ((u32x2*)(XB + (size_t)m * DM))[lane + 64 * j] = pack4(v[q][j]);
                    float s = dot4(v[q][j], v[q][j]);
                    s += __shfl_xor(s, 1); s += __shfl_xor(s, 2); s += __shfl_xor(s, 4); s += __shfl_xor(s, 8);
                    if ((lane & 15) == 0) SS[(size_t)m * 16 + 4 * j + (lane >> 4)] = s;
                }
                ((u32x2*)(PB + (size_t)m * PLE))[lane] = pack4(pv[q]);
            }
        }
    }
    {
        const int gt = blockIdx.x * 512 + threadIdx.x, NT = gridDim.x * 512;
        constexpr int NV = MS * 127 * 32;
        for (int i0 = gt; i0 < 2 * NV; i0 += 4 * NT) {
            f32x4 t[4]; float* dst[4];
#pragma unroll
            for (int q = 0; q < 4; ++q) {
                const int i = i0 + q * NT;
                if (i < 2 * NV) {
                    const int which = i >= NV, j = which ? i - NV : i;
                    const int b = j / (127 * 32), rem = j % (127 * 32), w = rem >> 5, c4 = rem & 31;
                    t[q] = *(const f32x4*)(a.in[2 + which] + ((size_t)(b * 128 + w + 1) * 128 + c4 * 4));
                    dst[q] = a.out + (which ? O_VWS : O_KWS) + ((size_t)(b * 128 + w) * 128 + c4 * 4);
                }
            }
#pragma unroll
            for (int q = 0; q < 4; ++q) if (i0 + q * NT < 2 * NV) *(f32x4*)dst[q] = t[q];
        }
    }
}

constexpr int KS_PITCH = 72, VT_PITCH = 264, VN_PITCH = 136;
__device__ __forceinline__ void attn_unit(LAS unsigned char* lds, int b, int h, int n, const bf16_t* Q, const bf16_t* Kb, const bf16_t* Vb, bf16_t* AB, const float* sinks) {
    const int tid = threadIdx.x, wid = __builtin_amdgcn_readfirstlane(tid >> 6), lane = tid & 63, fr = lane & 15, fq = lane >> 4;
    LAS bf16_t* Ks = (LAS bf16_t*)lds;
    LAS bf16_t* Vt = (LAS bf16_t*)(lds + 256 * KS_PITCH * 2);
    const bf16x8 zero8 = (bf16x8){0, 0, 0, 0, 0, 0, 0, 0};
    const int g = wid >> 1, ph = wid & 1, hq = h * 4 + g;
    bf16x8 qf[4][2];
#pragma unroll
    for (int mt = 0; mt < 4; ++mt)
#pragma unroll
        for (int kd = 0; kd < 2; ++kd) qf[mt][kd] = *(const bf16x8*)(Q + (size_t)(b * SEQ + n * 128 + ph * 64 + mt * 16 + fr) * 512 + hq * 64 + kd * 32 + fq * 8);
    const float sink = sinks[hq];
    {
        const int key = tid >> 1, half = tid & 1, kpos = (n - 1) * 128 + key;
        bf16x8 v[4];
#pragma unroll
        for (int j = 0; j < 4; ++j) v[j] = zero8;
        if (kpos >= 0) { const bf16x8* src = (const bf16x8*)(Kb + (size_t)(b * SEQ + kpos) * 128 + h * 64 + half * 32);
#pragma unroll
            for (int j = 0; j < 4; ++j) v[j] = src[j]; }
        bf16x8 v0[2], v1[2];
#pragma unroll
        for (int t2 = 0; t2 < 2; ++t2) {
            const int task = tid + 512 * t2, kp = task & 127, dc = task >> 7, c = 2 * kp, vpos = (n - 1) * 128 + c;
            v0[t2] = zero8; v1[t2] = zero8;
            if (vpos >= 0) { const bf16_t* src = Vb + (size_t)(b * SEQ + vpos) * 128 + h * 64 + dc * 8; v0[t2] = *(const bf16x8*)src; v1[t2] = *(const bf16x8*)(src + 128); }
        }
#pragma unroll
        for (int j = 0; j < 4; ++j) *(LAS bf16x8*)(Ks + key * KS_PITCH + half * 32 + j * 8) = v[j];
#pragma unroll
        for (int t2 = 0; t2 < 2; ++t2) {
            const int task = tid + 512 * t2, kp = task & 127, dc = task >> 7, c = 2 * kp;
#pragma unroll
            for (int e = 0; e < 8; ++e) *(LAS unsigned*)(Vt + (dc * 8 + e) * VT_PITCH + c) = (unsigned)(unsigned short)v0[t2][e] | ((unsigned)(unsigned short)v1[t2][e] << 16);
        }
    }
    __syncthreads();
#pragma unroll
    for (int mt = 0; mt < 4; ++mt) {
        const int p0 = ph * 64 + mt * 16, p = p0 + fr, kt0 = p0 >> 5;
        const size_t qrow = (size_t)(b * SEQ + n * 128 + p);
        f32x4 s[5][2];
#pragma unroll
        for (int j = 0; j < 5; ++j)
#pragma unroll
            for (int hh = 0; hh < 2; ++hh) {
                const int c0 = 32 * (kt0 + j) + 16 * hh;
                f32x4 acc = (f32x4){0.f, 0.f, 0.f, 0.f};
#pragma unroll
                for (int kd = 0; kd < 2; ++kd) { const bf16x8 kf = *(const LAS bf16x8*)(Ks + (c0 + fr) * KS_PITCH + kd * 32 + fq * 8); acc = __builtin_amdgcn_mfma_f32_16x16x32_bf16(kf, qf[mt][kd], acc, 0, 0, 0); }
                s[j][hh] = acc;
            }
        float mx = -INFINITY;
#pragma unroll
        for (int j = 0; j < 5; ++j)
#pragma unroll
            for (int hh = 0; hh < 2; ++hh)
#pragma unroll
                for (int i = 0; i < 4; ++i) {
                    const int c = 32 * (kt0 + j) + 16 * hh + 4 * fq + i;
                    const bool vis = (c >= p) && (c <= p + 128) && (n > 0 || c >= 128);
                    const float v = vis ? s[j][hh][i] : -INFINITY;
                    s[j][hh][i] = v; mx = fmaxf(mx, v);
                }
        mx = fmaxf(mx, __shfl_xor(mx, 16)); mx = fmaxf(mx, __shfl_xor(mx, 32)); mx = fmaxf(mx, sink);
        float sum = 0.f;
#pragma unroll
        for (int j = 0; j < 5; ++j)
#pragma unroll
            for (int hh = 0; hh < 2; ++hh)
#pragma unroll
                for (int i = 0; i < 4; ++i) { const float e = fast_exp(s[j][hh][i] - mx); s[j][hh][i] = e; sum += e; }
        sum += __shfl_xor(sum, 16); sum += __shfl_xor(sum, 32); sum += fast_exp(sink - mx);
        const float inv = 1.0f / sum;
        f32x4 o[4];
#pragma unroll
        for (int dt = 0; dt < 4; ++dt) o[dt] = (f32x4){0.f, 0.f, 0.f, 0.f};
#pragma unroll
        for (int j = 0; j < 5; ++j) {
            const u32x2 plo = pack4(s[j][0]), phi = pack4(s[j][1]);
            const u32x4 pw = (u32x4){plo.x, plo.y, phi.x, phi.y};
            const bf16x8 pf = __builtin_bit_cast(bf16x8, pw);
#pragma unroll
            for (int dt = 0; dt < 4; ++dt) {
                const LAS bf16_t* vp = Vt + (16 * dt + fr) * VT_PITCH + 32 * (kt0 + j) + 4 * fq;
                const u32x2 lo = *(const LAS u32x2*)vp, hi = *(const LAS u32x2*)(vp + 16);
                const u32x4 vw = (u32x4){lo.x, lo.y, hi.x, hi.y};
                o[dt] = __builtin_amdgcn_mfma_f32_16x16x32_bf16(__builtin_bit_cast(bf16x8, vw), pf, o[dt], 0, 0, 0);
            }
        }
#pragma unroll
        for (int dt = 0; dt < 4; ++dt) *(u32x2*)(AB + qrow * DM + hq * 64 + 16 * dt + 4 * fq) = pack4(o[dt] * inv);
    }
    __syncthreads();
}

__device__ __forceinline__ void gmlp_unit(LAS unsigned char* lds, int b, int n, int g, const bf16_t* GU, const bf16_t* GV, const float* LNP, bf16_t* AB,
                                          const float* ln_g, const float* ln_b, const float* w_s, const float* b_s, float* out) {
    const int tid = threadIdx.x, wid = __builtin_amdgcn_readfirstlane(tid >> 6), lane = tid & 63, fr = lane & 15, fq = lane >> 4;
    LAS bf16_t* vnT = (LAS bf16_t*)lds;
    const size_t row0 = (size_t)(b * SEQ + n * 128);
    const int t = 16 * wid + fr, nks = (wid >> 1) + 1;
    const size_t row = row0 + t;
    bf16x8 wf[4];
#pragma unroll
    for (int ks = 0; ks < 4; ++ks) {
        wf[ks] = (bf16x8){0, 0, 0, 0, 0, 0, 0, 0};
        if (ks < nks) {
            const int s0 = 32 * ks + 8 * fq;
            const float* wp = w_s + ((size_t)(g * 128 + t) * 128 + s0);
            const f32x4 w0 = *(const f32x4*)wp, w1 = *(const f32x4*)(wp + 4);
            float wv[8] = {w0[0], w0[1], w0[2], w0[3], w1[0], w1[1], w1[2], w1[3]};
#pragma unroll
            for (int e = 0; e < 8; ++e) wv[e] = (s0 + e <= t) ? wv[e] : 0.f;
            const u32x4 ww = (u32x4){pg8::cvt_pk_bf16(wv[0], wv[1]), pg8::cvt_pk_bf16(wv[2], wv[3]), pg8::cvt_pk_bf16(wv[4], wv[5]), pg8::cvt_pk_bf16(wv[6], wv[7])};
            wf[ks] = __builtin_bit_cast(bf16x8, ww);
        }
    }
    u32x2 guw[8];
#pragma unroll
    for (int ct = 0; ct < 8; ++ct) guw[ct] = *(const u32x2*)(GU + row * 512 + g * 128 + 16 * ct + 4 * fq);
    const float bias = b_s[g * 128 + t];
#pragma unroll
    for (int t2 = 0; t2 < 2; ++t2) {
        const int task = tid + 512 * t2, sp = task & 63, cc = task >> 6, s = 2 * sp;
        float mean[2], rstd[2]; f32x4 x[2][2];
#pragma unroll
        for (int rr = 0; rr < 2; ++rr) {
            const f32x4* lp = (const f32x4*)(LNP + (row0 + s + rr) * 16);
            float su = 0.f, sq = 0.f;
#pragma unroll
            for (int k = 0; k < 4; ++k) { const f32x4 tt = lp[k]; su += tt[0] + tt[2]; sq += tt[1] + tt[3]; }
            mean[rr] = su * (1.0f / 512.0f);
            const float var = fmaxf(sq * (1.0f / 512.0f) - mean[rr] * mean[rr], 0.f);
            rstd[rr] = __builtin_amdgcn_rsqf(var + LN_EPS);
            const u32x4 w = *(const u32x4*)(GV + (row0 + s + rr) * 512 + g * 128 + cc * 8);
            x[rr][0] = unpack4((u32x2){w.x, w.y}); x[rr][1] = unpack4((u32x2){w.z, w.w});
        }
        const f32x4 g0 = *(const f32x4*)(ln_g + g * 128 + cc * 8), g1 = *(const f32x4*)(ln_g + g * 128 + cc * 8 + 4);
        const f32x4 b0 = *(const f32x4*)(ln_b + g * 128 + cc * 8), b1 = *(const f32x4*)(ln_b + g * 128 + cc * 8 + 4);
#pragma unroll
        for (int rr = 0; rr < 2; ++rr) { x[rr][0] = (x[rr][0] - mean[rr]) * rstd[rr] * g0 + b0; x[rr][1] = (x[rr][1] - mean[rr]) * rstd[rr] * g1 + b1; }
        if (n == SEQ / 128 - 1) {
#pragma unroll
            for (int rr = 0; rr < 2; ++rr) { float* o = out + O_GVP + ((size_t)(b * 128 + s + rr) * 512 + g * 128 + cc * 8); *(f32x4*)o = x[rr][0]; *(f32x4*)(o + 4) = x[rr][1]; }
        }
#pragma unroll
        for (int e = 0; e < 8; ++e) *(LAS unsigned*)(vnT + (cc * 8 + e) * VN_PITCH + s) = pg8::cvt_pk_bf16(x[0][e >> 2][e & 3], x[1][e >> 2][e & 3]);
    }
    __syncthreads();
    f32x4 acc[8];
#pragma unroll
    for (int ct = 0; ct < 8; ++ct) acc[ct] = (f32x4){0.f, 0.f, 0.f, 0.f};
#pragma unroll
    for (int ks = 0; ks < 4; ++ks) {
        if (ks < nks) {
#pragma unroll
            for (int ct = 0; ct < 8; ++ct) {
                const bf16x8 vf = *(const LAS bf16x8*)(vnT + (16 * ct + fr) * VN_PITCH + 32 * ks + 8 * fq);
                acc[ct] = __builtin_amdgcn_mfma_f32_16x16x32_bf16(vf, wf[ks], acc[ct], 0, 0, 0);
            }
        }
    }
#pragma unroll
    for (int ct = 0; ct < 8; ++ct) *(u32x2*)(AB + row * DM + 512 + g * 128 + 16 * ct + 4 * fq) = pack4(unpack4(guw[ct]) * (acc[ct] + bias));
    __syncthreads();
}

__device__ __forceinline__ void sample_mixer(LAS unsigned char* lds, int b, const Args& a, const bf16_t* Q, const bf16_t* GU, const bf16_t* GV, bf16_t* AB) {
    const int tid = threadIdx.x, wid = __builtin_amdgcn_readfirstlane(tid >> 6), lane = tid & 63;
    LAS float* qs = (LAS float*)lds;
    LAS float* pw = (LAS float*)(lds + 2048) + wid * 136;
    LAS float* rs = (LAS float*)(lds + 2048 + 8 * 136 * 4);
    const size_t row = (size_t)MP + b;
    qs[tid] = bf2f(Q[row * 512 + tid]);
    const float gv = bf2f(GV[row * 512 + tid]);
    const float guv = bf2f(GU[row * 512 + tid]);
    {
        float su = gv, sq = gv * gv;
#pragma unroll
        for (int o = 1; o < 64; o <<= 1) { su += __shfl_xor(su, o); sq += __shfl_xor(sq, o); }
        if (lane == 0) { rs[wid] = su; rs[8 + wid] = sq; }
    }
    __syncthreads();
    {
        float su = 0.f, sq = 0.f;
#pragma unroll
        for (int w = 0; w < 8; ++w) { su += rs[w]; sq += rs[8 + w]; }
        const float mean = su * (1.0f / 512.0f), var = fmaxf(sq * (1.0f / 512.0f) - mean * mean, 0.f), rstd = __builtin_amdgcn_rsqf(var + LN_EPS);
        const float vn = (gv - mean) * rstd * a.in[14][tid] + a.in[15][tid];
        a.out[O_GVS + (size_t)b * 512 + tid] = vn;
        const int g = tid >> 7;
        const float mix = a.in[16][(size_t)g * 128 * 128] * vn + a.in[17][g * 128];
        AB[row * DM + 512 + tid] = (bf16_t)(pg8::cvt_pk_bf16(guv * mix, 0.f) & 0xffffu);
    }
    {
        const int hq = wid, kvh = hq >> 2;
        const f32x4* k0 = (const f32x4*)(a.in[2] + ((size_t)(b * 128 + lane) * 2 + kvh) * 64);
        const f32x4* k1 = (const f32x4*)(a.in[2] + ((size_t)(b * 128 + lane + 64) * 2 + kvh) * 64);
        const f32x4* kn = (const f32x4*)(a.out + O_KWS + ((size_t)(b * 128 + 127) * 2 + kvh) * 64);
        const LAS f32x4* q4 = (const LAS f32x4*)(qs + hq * 64);
        float s0 = 0.f, s1 = 0.f, s2 = 0.f;
#pragma unroll 8
        for (int d = 0; d < 16; ++d) { const f32x4 qv = q4[d]; s0 += dot4(qv, k0[d]); s1 += dot4(qv, k1[d]); s2 += dot4(qv, kn[d]); }
        const float sink = a.in[13][hq];
        float mx = fmaxf(fmaxf(s0, s1), s2);
#pragma unroll
        for (int o = 1; o < 64; o <<= 1) mx = fmaxf(mx, __shfl_xor(mx, o));
        mx = fmaxf(mx, sink);
        const float e0 = fast_exp(s0 - mx), e1 = fast_exp(s1 - mx), e2 = fast_exp(s2 - mx);
        float sum = e0 + e1;
#pragma unroll
        for (int o = 1; o < 64; o <<= 1) sum += __shfl_xor(sum, o);
        sum += e2 + fast_exp(sink - mx);
        pw[lane] = e0; pw[64 + lane] = e1;
        asm volatile("s_waitcnt lgkmcnt(0)" ::: "memory");
        const int cpart = lane >> 4, dch = lane & 15;
        const float* vb = a.in[3] + ((size_t)(b * 128 + cpart * 32) * 2 + kvh) * 64 + dch * 4;
        f32x4 o = (f32x4){0.f, 0.f, 0.f, 0.f};
#pragma unroll
        for (int hb = 0; hb < 2; ++hb) {
            f32x4 vv[16];
#pragma unroll
            for (int c = 0; c < 16; ++c) vv[c] = *(const f32x4*)(vb + (size_t)(hb * 16 + c) * 128);
#pragma unroll
            for (int c = 0; c < 16; ++c) o = o + vv[c] * pw[cpart * 32 + hb * 16 + c];
        }
#pragma unroll
        for (int i = 0; i < 4; ++i) { o[i] += __shfl_xor(o[i], 16); o[i] += __shfl_xor(o[i], 32); }
        if (cpart == 0) {
            const f32x4 vn4 = *(const f32x4*)(a.out + O_VWS + ((size_t)(b * 128 + 127) * 2 + kvh) * 64 + dch * 4);
            o = (o + vn4 * e2) * (1.0f / sum);
            *(u32x2*)(AB + row * DM + hq * 64 + dch * 4) = pack4(o);
        }
    }
    __syncthreads();
}

#define XB_TMO      128
#define XB_XCNT(j)  (256  + 64 * (j))
#define XB_XSUB(j)  (1280 + 64 * (j))
#define XB_XGEN(j)  (2304 + 64 * (j))
#define XB_TOP      3328
#define XB_TOPGEN   3392
#define XCD_BAR_WORDS 3456
#define XB_SPIN_CAP (1u << 18)

__device__ __forceinline__ unsigned xb_ld(unsigned* p)              { return __hip_atomic_load(p, __ATOMIC_RELAXED, __HIP_MEMORY_SCOPE_AGENT); }
__device__ __forceinline__ unsigned xb_add(unsigned* p, unsigned v) { return __hip_atomic_fetch_add(p, v, __ATOMIC_RELAXED, __HIP_MEMORY_SCOPE_AGENT); }
__device__ __forceinline__ unsigned xb_xcc_id() { return (unsigned)__builtin_amdgcn_s_getreg((3 << 11) | 20) & 0xFu; }
#define XB_SPIN(cond, bar) do { unsigned _sp = 0; while (cond) { __builtin_amdgcn_s_sleep(1); \
    if ((++_sp & 255u) == 0u) { if (xb_ld(&(bar)[XB_TMO])) break; if (_sp > XB_SPIN_CAP) { atomicAdd(&(bar)[XB_TMO], 1u); break; } } } } while (0)

struct XcdBarrier {
    unsigned* bar; unsigned x;
    volatile LAS unsigned* st;
};

__device__ __forceinline__ XcdBarrier xcd_barrier_post(unsigned* bar, volatile LAS unsigned* st) {
    XcdBarrier b; b.bar = bar; b.x = xb_xcc_id(); b.st = st;
    if (threadIdx.x == 0) (void)xb_add(&bar[XB_XCNT(b.x)], 1u);
    return b;
}
__device__ __forceinline__ void xcd_barrier_complete(unsigned* bar, unsigned x, unsigned& nloc, unsigned& nx) {
    const unsigned G = gridDim.x * gridDim.y * gridDim.z;
    unsigned sum, cnt, mine, sp = 0u;
    for (;;) {
        sum = 0u; cnt = 0u; mine = 0u;
#pragma unroll
        for (unsigned j = 0; j < 16; ++j) { const unsigned c = xb_ld(&bar[XB_XCNT(j)]); sum += c; cnt += (c > 0u) ? 1u : 0u; mine = (j == x) ? c : mine; }
        if (sum == G) break;
        __builtin_amdgcn_s_sleep(1);
        if ((++sp & 255u) == 0u) { if (xb_ld(&bar[XB_TMO])) break; if (sp > XB_SPIN_CAP) { atomicAdd(&bar[XB_TMO], 1u); break; } }
    }
    nloc = mine > 0u ? mine : 1u; nx = cnt > 0u ? cnt : 1u;
}

__device__ __forceinline__ void xcd_barrier(const XcdBarrier& b) {
    asm volatile("s_waitcnt vmcnt(0)" ::: "memory");
    __syncthreads();
    if (threadIdx.x == 0) {
        unsigned* bar = b.bar;
        __builtin_amdgcn_s_waitcnt(0);
        unsigned nloc = b.st[0], nx = b.st[1];
        if (nloc == 0u) { xcd_barrier_complete(bar, b.x, nloc, nx); b.st[0] = nloc; b.st[1] = nx; }
        const unsigned old = xb_add(&bar[XB_XSUB(b.x)], 1u);
        const unsigned gen = old / nloc;
        if (old + 1u == (gen + 1u) * nloc) {
            __builtin_amdgcn_fence(__ATOMIC_RELEASE, "agent");
            asm volatile("s_waitcnt vmcnt(0)" ::: "memory");
            const unsigned og = xb_add(&bar[XB_TOP], 1u);
            const unsigned tg = og / nx;
            if (og + 1u == (tg + 1u) * nx) xb_add(&bar[XB_TOPGEN], 1u);
            else XB_SPIN(xb_ld(&bar[XB_TOPGEN]) == tg, bar);
            __builtin_amdgcn_fence(__ATOMIC_ACQUIRE, "agent");
            xb_add(&bar[XB_XGEN(b.x)], 1u);
            asm volatile("s_waitcnt vmcnt(0)" ::: "memory");
        } else {
            XB_SPIN(xb_ld(&bar[XB_XGEN(b.x)]) == gen, bar);
            __builtin_amdgcn_fence(__ATOMIC_ACQUIRE, "agent");
            asm volatile("s_waitcnt vmcnt(0)" ::: "memory");
        }
    }
    __syncthreads();
}

template <bool COOP>
__global__ void __launch_bounds__(512, 2) mk_fwd(Args a) {
    extern __shared__ __attribute__((aligned(16))) unsigned char lds_raw[];
    LAS unsigned char* lds = (LAS unsigned char*)lds_raw;
    const int tid = threadIdx.x, wid = __builtin_amdgcn_readfirstlane(tid >> 6), lane = tid & 63;
    const int G = gridDim.x, bx = blockIdx.x;
    unsigned char* ws = a.ws;
    bf16_t* W13A = (bf16_t*)(ws + WS_W13A); bf16_t* W2A = (bf16_t*)(ws + WS_W2A); bf16_t* W13B = (bf16_t*)(ws + WS_W13B); bf16_t* W2B = (bf16_t*)(ws + WS_W2B);
    bf16_t* WIN = (bf16_t*)(ws + WS_WIN); bf16_t* WOUT = (bf16_t*)(ws + WS_WOUT); bf16_t* WG = (bf16_t*)(ws + WS_WG); bf16_t* WP = (bf16_t*)(ws + WS_WP);
    bf16_t* XB = (bf16_t*)(ws + WS_XB); bf16_t* PB = (bf16_t*)(ws + WS_PB); bf16_t* PP = (bf16_t*)(ws + WS_PP);
    float* SS = (float*)(ws + WS_SS); float* LNP = (float*)(ws + WS_LNP);
    bf16_t* H = (bf16_t*)(ws + WS_H); bf16_t* Qb = (bf16_t*)(ws + WS_Q); bf16_t* Kb = (bf16_t*)(ws + WS_K); bf16_t* Vb = (bf16_t*)(ws + WS_V);
    bf16_t* GU = (bf16_t*)(ws + WS_GU); bf16_t* GV = (bf16_t*)(ws + WS_GV); bf16_t* AB = (bf16_t*)(ws + WS_AB);
    float* X = a.out;
    const int lo = a.ph_lo, hi = a.ph_hi;
    XcdBarrier bar; bar.bar = (unsigned*)(ws + WS_CTL); bar.x = 0; bar.st = (volatile LAS unsigned*)(lds + LDS_ST_OFF);
    if constexpr (COOP) {
        if (tid < 2) bar.st[tid] = 0u;
        __syncthreads();
        bar = xcd_barrier_post((unsigned*)(ws + WS_CTL), (volatile LAS unsigned*)(lds + LDS_ST_OFF));
        if (hi > 1000) cg::this_grid().sync();
    }
#define IN(k) (lo <= (k) && (k) < hi)
#define SEAM(k) do { if constexpr (COOP) { if (IN(k) && IN((k) + 1)) xcd_barrier(bar); } } while (0)

    if (IN(0)) p0_prologue(a, lds, wid, lane);
    SEAM(0);
    if (IN(1)) {
        pg8::Gemm g{XB, W13A, MP, 2 * FF, DM}; pg8::StaticOrder S; S.init(MP, 2 * FF, G, bx);
        EpiMain<QSwiglu> E{QSwiglu{H}, SS};
        pg8::gemm_phase<EpiMain<QSwiglu>, pg8::StaticOrder, true, true>(lds, g, S, E);
        skinny_gemm<QSwiglu>(lds, XB + (size_t)MP * DM, W13A, FF, DM, E.q, bx, G);
    }
    SEAM(1);
    if (IN(2)) {
        pg8::Gemm g{H, W2A, MP, DM, FF}; pg8::StaticOrder S; S.init(MP, DM, G, bx);
        EpiMain<QResid> E{QResid{XB, nullptr, SS, 0.5f}, nullptr};
        pg8::gemm_phase<EpiMain<QResid>, pg8::StaticOrder, true, true>(lds, g, S, E);
        skinny_gemm<QResid>(lds, H + (size_t)MP * FF, W2A, DM, FF, E.q, bx, G);
    }
    SEAM(2);
    if (IN(3)) {
        {
            pg8::Gemm g{XB, WIN, MP, NIN, DM}; pg8::StaticOrder S; S.init(MP, NIN, G, bx);
            EpiMain<QWin> E{QWin{a.in[12], Qb, Kb, Vb, GU, GV, LNP, a.out}, SS};
            pg8::gemm_phase<EpiMain<QWin>, pg8::StaticOrder, true, true>(lds, g, S, E);
            skinny_gemm<QWin>(lds, XB + (size_t)MP * DM, WIN, NIN, DM, E.q, bx, G);
        }
        {
            int kp = PLE; asm volatile("" : "+s"(kp));
            pg8::Gemm g{PB, WP, MP, DM, kp}; UpperOrder S; S.init(MP, DM, G, bx);
            EpiMain<QProj> E{QProj{PP}, nullptr};
            pg8::gemm_phase<EpiMain<QProj>, UpperOrder, true, true>(lds, g, S, E);
            skinny_gemm<QProj>(lds, PB + (size_t)MP * PLE, WP, DM, PLE, E.q, bx, G);
        }
    }
    SEAM(3);
    if (IN(4)) {
        for (int u = bx; u < NBATCH * 2 * 32; u += G) { const int n = u & 31, h = (u >> 5) & 1, b = u >> 6; attn_unit(lds, b, h, n, Qb, Kb, Vb, AB, a.in[13]); }
        for (int u = bx; u < NBATCH * 32 * 4; u += G) { const int g = u & 3, n = (u >> 2) & 31, b = u >> 7; gmlp_unit(lds, b, n, g, GU, GV, LNP, AB, a.in[14], a.in[15], a.in[16], a.in[17], a.out); }
        for (int u = bx; u < MS; u += G) sample_mixer(lds, u, a, Qb, GU, GV, AB);
    }
    SEAM(4);
    if (IN(5)) {
        pg8::Gemm g{AB, WOUT, MP, DM, DM}; pg8::StaticOrder S; S.init(MP, DM, G, bx);
        EpiMain<QResid> E{QResid{XB, a.in[19], SS, 1.0f}, nullptr};
        pg8::gemm_phase<EpiMain<QResid>, pg8::StaticOrder, true, true>(lds, g, S, E);
        skinny_gemm<QResid>(lds, AB + (size_t)MP * DM, WOUT, DM, DM, E.q, bx, G);
    }
    SEAM(5);
    if (IN(6)) {
        pg8::Gemm g{XB, W13B, MP, 2 * FF, DM}; pg8::StaticOrder S; S.init(MP, 2 * FF, G, bx);
        EpiMain<QSwiglu> E{QSwiglu{H}, SS};
        pg8::gemm_phase<EpiMain<QSwiglu>, pg8::StaticOrder, true, true>(lds, g, S, E);
        skinny_gemm<QSwiglu>(lds, XB + (size_t)MP * DM, W13B, FF, DM, E.q, bx, G);
    }
    SEAM(6);
    if (IN(7)) {
        pg8::Gemm g{H, W2B, MP, DM, FF}; pg8::StaticOrder S; S.init(MP, DM, G, bx);
        EpiMain<QResid> E{QResid{XB, nullptr, SS, 0.5f}, nullptr};
        pg8::gemm_phase<EpiMain<QResid>, pg8::StaticOrder, true, true>(lds, g, S, E);
        skinny_gemm<QResid>(lds, H + (size_t)MP * FF, W2B, DM, FF, E.q, bx, G);
    }
    SEAM(7);
    if (IN(8)) {
        pg8::Gemm g{XB, WG, MP, DM, DM}; pg8::StaticOrder S; S.init(MP, DM, G, bx);
        EpiMain<QGate> E{QGate{H, XB, PP}, SS};
        pg8::gemm_phase<EpiMain<QGate>, pg8::StaticOrder, true, true>(lds, g, S, E);
        skinny_gemm<QGate>(lds, XB + (size_t)MP * DM, WG, DM, DM, E.q, bx, G);
    }
    SEAM(8);
    if (IN(9)) {
        const int gw = bx * 8 + wid, NGW = G * 8;
        const float* gf = a.in[27];
        f32x4 gg[4];
#pragma unroll
        for (int j = 0; j < 4; ++j) gg[j] = ((const f32x4*)gf)[lane + 64 * j];
        for (int m0 = gw; m0 < MT; m0 += 4 * NGW) {
            u32x2 w[4][4];
#pragma unroll
            for (int q = 0; q < 4; ++q) { const int m = m0 + q * NGW; if (m < MT) {
#pragma unroll
                for (int j = 0; j < 4; ++j) w[q][j] = ((const u32x2*)(H + (size_t)m * DM))[lane + 64 * j]; } }
#pragma unroll
            for (int q = 0; q < 4; ++q) { const int m = m0 + q * NGW; if (m < MT) {
                f32x4* yr = (f32x4*)(X + (size_t)m * DM);
                f32x4 v[4]; float s = 0.f;
#pragma unroll
                for (int j = 0; j < 4; ++j) { v[j] = unpack4(w[q][j]); s += dot4(v[j], v[j]); }
#pragma unroll
                for (int o = 1; o < 64; o <<= 1) s += __shfl_xor(s, o);
                const float r = __builtin_amdgcn_rsqf(s * (1.0f / DM) + RMS_EPS);
#pragma unroll
                for (int j = 0; j < 4; ++j) yr[lane + 64 * j] = v[j] * r * gg[j]; } }
        }
    }
#undef IN
#undef SEAM
}

extern "C" void kernel_launch(void* const* d_in, const int* in_sizes, int n_in, void* d_out, int out_size, void* d_ws, size_t ws_size, hipStream_t stream) {
    static int grid = 0;
    constexpr bool COOP = (MK_COOP != 0);
    const void* fn = (const void*)mk_fwd<COOP>;
    if (grid == 0) {
        if (n_in != 28 || (size_t)out_size != O_END || ws_size < WS_TOTAL) { fprintf(stderr, "kernel_launch: unexpected shapes (n_in %d out %d ws %zu, need %zu)\n", n_in, out_size, ws_size, (size_t)WS_TOTAL); grid = -1; return; }
        int dev = 0, cus = 0, per_cu = 0;
        (void)hipGetDevice(&dev);
        (void)hipDeviceGetAttribute(&cus, hipDeviceAttributeMultiprocessorCount, dev);
        if (hipFuncSetAttribute(fn, hipFuncAttributeMaxDynamicSharedMemorySize, LDS_BYTES) != hipSuccess) { fprintf(stderr, "kernel_launch: hipFuncSetAttribute failed\n"); grid = -1; return; }
        if (hipOccupancyMaxActiveBlocksPerMultiprocessor(&per_cu, fn, 512, LDS_BYTES) != hipSuccess || per_cu < 1) { fprintf(stderr, "kernel_launch: occupancy query says %d\n", per_cu); per_cu = 1; }
        (void)hipGetLastError();
        grid = cus;
    }
    if (grid < 0) return;
    Args a{};
    for (int i = 0; i < 28; ++i) a.in[i] = (const float*)d_in[i];
    a.out = (float*)d_out; a.ws = (unsigned char*)d_ws;
    if (COOP) {
        if (hipMemsetAsync((char*)d_ws + WS_CTL, 0, CTL_BYTES, stream) != hipSuccess) { fprintf(stderr, "kernel_launch: memset of the barrier words failed\n"); return; }
        a.ph_lo = 0; a.ph_hi = NPHASE;
        void* args[] = {&a};
        hipError_t e = hipLaunchCooperativeKernel(fn, dim3(grid), dim3(512), args, LDS_BYTES, stream);
        if (e != hipSuccess) fprintf(stderr, "cooperative launch failed: %s (grid %d)\n", hipGetErrorString(e), grid);
    } else {
        for (int p = 0; p < NPHASE; ++p) { a.ph_lo = p; a.ph_hi = p + 1; hipLaunchKernelGGL(mk_fwd<COOP>, dim3(grid), dim3(512), LDS_BYTES, stream, a); }
    }
}
```

```cpp
#include <hip/hip_runtime.h>
#include <hip/hip_cooperative_groups.h>
#include <cstdio>
#include <cstdint>
namespace cg = cooperative_groups;
namespace pg8 {
#define PG8_LAS __attribute__((address_space(3)))
typedef unsigned short bf16_t;
typedef short bf16x8 __attribute__((ext_vector_type(8)));
typedef float f32x4 __attribute__((ext_vector_type(4)));
typedef unsigned u32x4 __attribute__((ext_vector_type(4)));
constexpr int BM = 256, BK = 64, HALF = 128, HTB = HALF * BK * 2  , STAGE_BYTES = 8 * HTB, NXCD = 8, WGM = 8;

__host__ __device__ __forceinline__ int lds_byte(int r, int c) { const int st = (r >> 4) * 2 + (c >> 5), rr = r & 15, cc = c & 31, ob = rr * 64 + cc * 2; return st * 1024 + (ob ^ (((ob >> 9) & 1) << 5)); }
__host__ __device__ __forceinline__ void stage_rc(int b, int& R, int& C) { const int st = b / 1024, sb = b % 1024, swz = sb ^ (((sb >> 9) & 1) << 5); R = (st >> 1) * 16 + swz / 64; C = (st & 1) * 32 + (swz % 64) / 2; }
__host__ __device__ __forceinline__ int perm32(int rho) { const int n = rho >> 4, i = rho & 15; return 8 * (i >> 2) + 4 * n + (i & 3); }

struct Unit { int pm, pn; };
struct Gemm { const bf16_t* A; const bf16_t* Bt; int M, N, K; };

struct StaticOrder {
    int nM, nN, nwg, G, c;
    __host__ __device__ void init(int M, int N, int G_, int c_) { nM = M / BM; nN = N / BM; nwg = nM * nN; G = G_; c = c_; }
    __host__ __device__ bool next(int i, Unit& u) const {
        const long L = (long)i * G + c; if (L >= nwg) return false;
        int wgid = (int)L; { const int q = nwg / NXCD, r = nwg % NXCD, xcd = wgid % NXCD, off = wgid / NXCD; wgid = (xcd < r ? xcd * (q + 1) : r * (q + 1) + (xcd - r) * q) + off; }
        const int nig = WGM * nN, gid = wgid / nig, fm = gid * WGM, gsz = (nM - fm) < WGM ? (nM - fm) : WGM;
        u.pm = fm + ((wgid % nig) % gsz); u.pn = (wgid % nig) / gsz; return true;
    }
    __device__ __forceinline__ void a_ready(const Unit&) const {}
    __device__ __forceinline__ void done(const Unit&) const {}
};

__device__ __forceinline__ unsigned cvt_pk_bf16(float lo, float hi) { unsigned r; asm volatile("v_cvt_pk_bf16_f32 %0, %1, %2" : "=v"(r) : "v"(lo), "v"(hi)); return r; }
typedef float f32x2 __attribute__((ext_vector_type(2)));
template <class Epi, class Sched, bool ALIGN_EPI = false, bool SP2 = false>
__device__ __forceinline__ void gemm_phase(PG8_LAS unsigned char* lds, const Gemm g, const Sched& S, const Epi& E) {
    const int tid = threadIdx.x, wid = __builtin_amdgcn_readfirstlane(tid >> 6), lane = tid & 63, wr = wid >> 2, wc = wid & 3, fr = lane & 15, fq = lane >> 4;
    const int K = g.K, nt = K / BK;
    unsigned voffA[2], voffB[2];
#pragma unroll
    for (int i = 0; i < 2; ++i) { int R, C; stage_rc(tid * 16 + i * 8192, R, C); const int Rb = Epi::PERM ? ((R & ~31) + perm32(R & 31)) : R;
        voffA[i] = (unsigned)(R * K + C) * 2u; voffB[i] = (unsigned)(Rb * K + C) * 2u; }
    const size_t kstep = (size_t)(BK * 2);
    const size_t hstep = (size_t)HALF * K * 2;
    const size_t tstep = 2 * hstep;
    const unsigned ldsw = (unsigned)wid * 1024u;
    const int aoff = lds_byte(wr * 64 + fr, fq * 8), boff = lds_byte(wc * 32 + fr, fq * 8);
#define PG8_SA(b, h) (((b) * 2 + (h)) * HTB)
#define PG8_SB(b, h) ((4 + (b) * 2 + (h)) * HTB)
#define PG8_STAGE(bufoff, gbase, voff) do { _Pragma("unroll") for (int _i = 0; _i < 2; ++_i) \
        __builtin_amdgcn_global_load_lds((const unsigned*)((const char*)(gbase) + (voff)[_i]), (PG8_LAS unsigned*)(lds + (bufoff) + ldsw + _i * 8192), 16, 0, 0); } while (0)
#define PG8_LDA(dst, b, h) do { _Pragma("unroll") for (int m = 0; m < 4; ++m) _Pragma("unroll") for (int k = 0; k < 2; ++k) dst[m][k] = *(const PG8_LAS bf16x8*)(lds + PG8_SA(b, h) + aoff + m * 2048 + k * 1024); } while (0)
#define PG8_LDB(dst, b, h) do { _Pragma("unroll") for (int n = 0; n < 2; ++n) _Pragma("unroll") for (int k = 0; k < 2; ++k) dst[n][k] = *(const PG8_LAS bf16x8*)(lds + PG8_SB(b, h) + boff + n * 2048 + k * 1024); } while (0)
#define PG8_MMA(ai, bj, At, Bt) do { __builtin_amdgcn_s_setprio(1); _Pragma("unroll") for (int m = 0; m < 4; ++m) _Pragma("unroll") for (int n = 0; n < 2; ++n) _Pragma("unroll") for (int k = 0; k < 2; ++k) \
        acc[ai][bj][m][n] = __builtin_amdgcn_mfma_f32_16x16x32_bf16(Bt[n][k], At[m][k], acc[ai][bj][m][n], 0, 0, 0); __builtin_amdgcn_s_setprio(0); } while (0)
#define PG8_WAIT_V(n) asm volatile("s_waitcnt vmcnt(" #n ")" ::: "memory")
#define PG8_WAIT_L(n) asm volatile("s_waitcnt lgkmcnt(" #n ")" ::: "memory")
#define PG8_BAR __builtin_amdgcn_s_barrier()
#define PG8_SCHED __builtin_amdgcn_sched_barrier(0)
    Unit cur, nxt; int ui = 0;
    if (!S.next(0, cur)) return;
    f32x4 acc[2][2][4][2];
#pragma unroll
    for (int a = 0; a < 2; ++a)
#pragma unroll
        for (int b = 0; b < 2; ++b)
#pragma unroll
            for (int m = 0; m < 4; ++m)
#pragma unroll
                for (int n = 0; n < 2; ++n) acc[a][b][m][n] = (f32x4){0.f, 0.f, 0.f, 0.f};
    bf16x8 At[4][2], B0[2][2], B1[2][2];
    const char* cA = (const char*)g.A + (size_t)cur.pm * tstep; const char* cB = (const char*)g.Bt + (size_t)cur.pn * tstep;
    S.a_ready(cur);
    if constexpr (SP2) {
        PG8_STAGE(PG8_SB(0, 0), cB, voffB); PG8_STAGE(PG8_SB(0, 1), cB + hstep, voffB); PG8_STAGE(PG8_SA(0, 0), cA, voffA); PG8_STAGE(PG8_SA(0, 1), cA + hstep, voffA);
        if (wr == 1) PG8_BAR;
        PG8_WAIT_V(2); PG8_BAR;
        PG8_STAGE(PG8_SB(1, 0), cB + kstep, voffB); PG8_STAGE(PG8_SA(1, 0), cA + kstep, voffA); PG8_STAGE(PG8_SB(1, 1), cB + hstep + kstep, voffB);
        PG8_WAIT_V(6); PG8_BAR;
    } else {
        PG8_STAGE(PG8_SB(0, 0), cB, voffB); PG8_STAGE(PG8_SA(0, 0), cA, voffA); PG8_STAGE(PG8_SB(0, 1), cB + hstep, voffB); PG8_STAGE(PG8_SA(0, 1), cA + hstep, voffA);
        if (wr == 1) PG8_BAR;
        PG8_WAIT_V(4); PG8_BAR;
        PG8_STAGE(PG8_SB(1, 0), cB + kstep, voffB); PG8_STAGE(PG8_SA(1, 0), cA + kstep, voffA); PG8_STAGE(PG8_SB(1, 1), cB + hstep + kstep, voffB);
        PG8_WAIT_V(6); PG8_BAR;
    }
    for (;;) {
        const bool has_next = S.next(ui + 1, nxt);
        const char* nA = has_next ? (const char*)g.A + (size_t)nxt.pm * tstep : cA; const char* nB = has_next ? (const char*)g.Bt + (size_t)nxt.pn * tstep : cB;
        for (int t = 0; t < nt; t += 2) {
            const bool last = (t == nt - 2);
            const char* a1 = cA + (size_t)(t + 1) * kstep;
            const char* a2 = last ? nA : cA + (size_t)(t + 2) * kstep; const char* b2 = last ? nB : cB + (size_t)(t + 2) * kstep;
            const char* a3 = a2 + kstep; const char* b3 = b2 + kstep;
            if (last && has_next) S.a_ready(nxt);
            if constexpr (SP2) {
            PG8_LDB(B0, 0, 0); PG8_LDB(B1, 0, 1); PG8_SCHED; PG8_LDA(At, 0, 0); PG8_STAGE(PG8_SA(1, 1), a1 + hstep, voffA);
            PG8_WAIT_V(8); PG8_WAIT_L(0); PG8_BAR; PG8_MMA(0, 0, At, B0); PG8_MMA(0, 1, At, B1); PG8_BAR; PG8_SCHED;
            PG8_LDA(At, 0, 1); PG8_STAGE(PG8_SB(0, 0), b2, voffB); PG8_STAGE(PG8_SB(0, 1), b2 + hstep, voffB); PG8_STAGE(PG8_SA(0, 0), a2, voffA);
            PG8_WAIT_V(8); PG8_WAIT_L(0); PG8_BAR; PG8_MMA(1, 0, At, B0); PG8_MMA(1, 1, At, B1); PG8_BAR; PG8_SCHED;
            PG8_LDB(B0, 1, 0); PG8_LDB(B1, 1, 1); PG8_SCHED; PG8_LDA(At, 1, 0); PG8_STAGE(PG8_SA(0, 1), a2 + hstep, voffA);
            PG8_WAIT_V(8); PG8_WAIT_L(0); PG8_BAR; PG8_MMA(0, 0, At, B0); PG8_MMA(0, 1, At, B1); PG8_BAR; PG8_SCHED;
            PG8_LDA(At, 1, 1); PG8_STAGE(PG8_SB(1, 0), b3, voffB); PG8_STAGE(PG8_SB(1, 1), b3 + hstep, voffB); PG8_STAGE(PG8_SA(1, 0), a3, voffA);
            PG8_WAIT_V(8); PG8_WAIT_L(0); PG8_BAR; PG8_MMA(1, 0, At, B0); PG8_MMA(1, 1, At, B1); PG8_BAR; PG8_SCHED;
            } else {
            PG8_LDB(B0, 0, 0); PG8_SCHED; PG8_LDA(At, 0, 0); PG8_STAGE(PG8_SA(1, 1), a1 + hstep, voffA);
            PG8_WAIT_L(8); PG8_BAR; PG8_WAIT_L(0); PG8_MMA(0, 0, At, B0); PG8_BAR; PG8_SCHED;
            PG8_LDB(B1, 0, 1); PG8_STAGE(PG8_SB(0, 0), b2, voffB);
            PG8_BAR; PG8_WAIT_L(0); PG8_MMA(0, 1, At, B1); PG8_BAR;
            PG8_LDA(At, 0, 1); PG8_STAGE(PG8_SA(0, 0), a2, voffA);
            PG8_BAR; PG8_WAIT_L(0); PG8_MMA(1, 0, At, B0); PG8_BAR; PG8_SCHED;
            PG8_STAGE(PG8_SB(0, 1), b2 + hstep, voffB);
            PG8_WAIT_V(6); PG8_BAR; PG8_MMA(1, 1, At, B1); PG8_BAR;
            PG8_LDB(B0, 1, 0); PG8_SCHED; PG8_LDA(At, 1, 0); PG8_STAGE(PG8_SA(0, 1), a2 + hstep, voffA);
            PG8_WAIT_L(8); PG8_BAR; PG8_WAIT_L(0); PG8_MMA(0, 0, At, B0); PG8_BAR; PG8_SCHED;
            PG8_LDB(B1, 1, 1); PG8_STAGE(PG8_SB(1, 0), b3, voffB);
            PG8_BAR; PG8_WAIT_L(0); PG8_MMA(0, 1, At, B1); PG8_BAR;
            PG8_LDA(At, 1, 1); PG8_STAGE(PG8_SA(1, 0), a3, voffA);
            PG8_BAR; PG8_WAIT_L(0); PG8_MMA(1, 0, At, B0); PG8_BAR; PG8_SCHED;
            PG8_STAGE(PG8_SB(1, 1), b3 + hstep, voffB);
            PG8_WAIT_V(6); PG8_BAR; PG8_MMA(1, 1, At, B1); PG8_BAR;
            }
        }
        if constexpr (ALIGN_EPI) { if (wr == 0) PG8_BAR; }
        if constexpr (!Epi::AFTER_DRAIN) { E(acc, cur, wr, wc, fr, fq); S.done(cur); }
        if (!has_next) break;
#pragma unroll
        for (int a = 0; a < 2; ++a)
#pragma unroll
            for (int b = 0; b < 2; ++b)
#pragma unroll
                for (int m = 0; m < 4; ++m)
#pragma unroll
                    for (int n = 0; n < 2; ++n) acc[a][b][m][n] = (f32x4){0.f, 0.f, 0.f, 0.f};
        cur = nxt; cA = nA; cB = nB; ++ui;
        if constexpr (ALIGN_EPI) { if (wr == 1) PG8_BAR; }
    }
    PG8_WAIT_V(0);
    if constexpr (!ALIGN_EPI) { if (wr == 0) PG8_BAR; }
    PG8_BAR;
    if constexpr (Epi::AFTER_DRAIN) { E.fused(acc, cur, wr, wc, fr, fq, lds, wid, lane); S.done(cur); }
#undef PG8_SA
#undef PG8_SB
#undef PG8_STAGE
#undef PG8_LDA
#undef PG8_LDB
#undef PG8_MMA
#undef PG8_WAIT_V
#undef PG8_WAIT_L
#undef PG8_BAR
#undef PG8_SCHED
}
}

#ifndef MK_COOP
#define MK_COOP 1
#endif

#define LAS __attribute__((address_space(3)))
typedef pg8::f32x4 f32x4;
typedef pg8::bf16_t bf16_t;
typedef pg8::bf16x8 bf16x8;
typedef unsigned u32x2 __attribute__((ext_vector_type(2)));
typedef unsigned u32x4 __attribute__((ext_vector_type(4)));

constexpr int DM = 1024, SEQ = 4096, NBATCH = 8, MP = NBATCH * SEQ, MS = 128, MT = MP + MS;
constexpr int FF = 2816, NIN = 1792, PLE = 256;
constexpr float RMS_EPS = 1e-6f, LN_EPS = 1e-5f;
constexpr int NPHASE = 10;

constexpr size_t O_Y = 0, O_KWP = (size_t)MT * DM, O_VWP = O_KWP + 131072, O_KWS = O_VWP + 131072, O_VWS = O_KWS + 2097152,
                 O_GVP = O_VWS + 2097152, O_GVS = O_GVP + 524288, O_END = O_GVS + 65536;

constexpr size_t al256(size_t x) { return (x + 255) & ~(size_t)255; }
constexpr size_t WS_W13A = 0;
constexpr size_t WS_W2A = al256(WS_W13A + (size_t)2 * FF * DM * 2);
constexpr size_t WS_W13B = al256(WS_W2A + (size_t)DM * FF * 2);
constexpr size_t WS_W2B = al256(WS_W13B + (size_t)2 * FF * DM * 2);
constexpr size_t WS_WIN = al256(WS_W2B + (size_t)DM * FF * 2);
constexpr size_t WS_WOUT = al256(WS_WIN + (size_t)NIN * DM * 2);
constexpr size_t WS_WG = al256(WS_WOUT + (size_t)DM * DM * 2);
constexpr size_t WS_WP = al256(WS_WG + (size_t)DM * DM * 2);
constexpr size_t WS_XB = al256(WS_WP + (size_t)DM * PLE * 2);
constexpr size_t WS_PB = al256(WS_XB + (size_t)MT * DM * 2);
constexpr size_t WS_PP = al256(WS_PB + (size_t)MT * PLE * 2);
constexpr size_t WS_SS = al256(WS_PP + (size_t)MT * DM * 2);
constexpr size_t WS_LNP = al256(WS_SS + (size_t)MT * 16 * 4);
constexpr size_t WS_H = al256(WS_LNP + (size_t)MT * 16 * 4);
constexpr size_t WS_Q = WS_H;
constexpr size_t WS_K = WS_Q + (size_t)MT * 512 * 2;
constexpr size_t WS_V = WS_K + (size_t)MT * 128 * 2;
constexpr size_t WS_GU = WS_V + (size_t)MT * 128 * 2;
constexpr size_t WS_GV = WS_GU + (size_t)MT * 512 * 2;
constexpr size_t WS_AB = WS_GV + (size_t)MT * 512 * 2;
constexpr size_t WS_END = al256(WS_H + (size_t)MT * FF * 2);
static_assert(WS_AB + (size_t)MT * DM * 2 <= WS_END, "overlay fits in h");
constexpr size_t WS_CTL = WS_END, CTL_BYTES = 16384, WS_TOTAL = WS_CTL + CTL_BYTES;
constexpr int LDS_ST_OFF = 131072 + 1024;

constexpr int LDS_BYTES = 147456;

__device__ __forceinline__ float bf2f(unsigned short b) { return __uint_as_float((unsigned)b << 16); }
__device__ __forceinline__ float fast_exp(float x) { return __builtin_amdgcn_exp2f(x * 1.44269504089f); }
__device__ __forceinline__ float sigmoid_(float x) { return __builtin_amdgcn_rcpf(1.f + fast_exp(-x)); }
__device__ __forceinline__ float silu_(float x) { return x * sigmoid_(x); }
__device__ __forceinline__ float gelu_(float x) { return x * sigmoid_(1.5957691216f * (x + 0.044715f * x * x * x)); }
__device__ __forceinline__ u32x2 pack4(f32x4 v) { u32x2 w; w.x = pg8::cvt_pk_bf16(v[0], v[1]); w.y = pg8::cvt_pk_bf16(v[2], v[3]); return w; }
__device__ __forceinline__ f32x4 unpack4(u32x2 w) { return (f32x4){__uint_as_float(w.x << 16), __uint_as_float(w.x & 0xffff0000u), __uint_as_float(w.y << 16), __uint_as_float(w.y & 0xffff0000u)}; }
__device__ __forceinline__ float dot4(f32x4 a, f32x4 b) { return (a[0] * b[0] + a[1] * b[1]) + (a[2] * b[2] + a[3] * b[3]); }

struct QSwiglu {
    static constexpr bool NEED_R = true, SWI = true, STAT = false;
    bf16_t* H;
    __device__ __forceinline__ void quad2(int row, int col, float r, f32x4 a, f32x4 b) const {
        typedef float f32x2 __attribute__((ext_vector_type(2)));
        const float nr = r * -1.44269504089f, r2 = r * r;
        unsigned w[2];
#pragma unroll
        for (int h = 0; h < 2; ++h) {
            const f32x2 a2 = (f32x2){a[2 * h], a[2 * h + 1]}, b2 = (f32x2){b[2 * h], b[2 * h + 1]};
            const f32x2 t = a2 * nr;
            f32x2 e; e.x = __builtin_amdgcn_exp2f(t.x); e.y = __builtin_amdgcn_exp2f(t.y);
            const f32x2 d = e + 1.0f;
            f32x2 q; q.x = __builtin_amdgcn_rcpf(d.x); q.y = __builtin_amdgcn_rcpf(d.y);
            const f32x2 o = ((a2 * b2) * r2) * q;
            w[h] = pg8::cvt_pk_bf16(o.x, o.y);
        }
        *(u32x2*)(H + (size_t)row * FF + col) = (u32x2){w[0], w[1]};
    }
};
struct QResid {
    static constexpr bool NEED_R = false, SWI = false, STAT = true;
    bf16_t* XB; const float* bias; float* SS; float scale;
    __device__ __forceinline__ float quad(int row, int col, float r, f32x4 v, float& s1) const {
        s1 = 0.f;
        u32x2* p = (u32x2*)(XB + (size_t)row * DM + col);
        f32x4 o = unpack4(*p) + v * scale;
        if (bias) o = o + *(const f32x4*)(bias + col);
        *p = pack4(o);
        return dot4(o, o);
    }
    __device__ __forceinline__ void rowstat(int row, int pn, int wc, float s0, float s1) const { SS[(size_t)row * 16 + pn * 4 + wc] = s0; }
};
struct QWin {
    static constexpr bool NEED_R = true, SWI = false, STAT = true;
    const float* bias; bf16_t *Q, *K, *V, *GU, *GV; float* LNP; float* out;
    __device__ __forceinline__ float quad(int row, int col, float r, f32x4 v, float& s1) const {
        const f32x4 z = v * r + *(const f32x4*)(bias + col);
        s1 = 0.f;
        const int cb = __builtin_amdgcn_readfirstlane(col >> 7);
        if (cb < 4) { *(u32x2*)(Q + (size_t)row * 512 + col) = pack4(z * 0.125f); return 0.f; }
        if (cb < 6) {
            const bool isk = cb == 4; const int c = col - (isk ? 512 : 640);
            *(u32x2*)((isk ? K : V) + (size_t)row * 128 + c) = pack4(z);
            if (row >= MP) { *(f32x4*)(out + (isk ? O_KWS : O_VWS) + ((size_t)(row - MP) * 128 + 127) * 128 + c) = z; }
            else { const int t = row & (SEQ - 1); if (t >= SEQ - 128) *(f32x4*)(out + (isk ? O_KWP : O_VWP) + ((size_t)(row >> 12) * 128 + (t - (SEQ - 128))) * 128 + c) = z; }
            return 0.f;
        }
        f32x4 g;
#pragma unroll
        for (int i = 0; i < 4; ++i) g[i] = gelu_(z[i]);
        if (cb < 10) { *(u32x2*)(GU + (size_t)row * 512 + (col - 768)) = pack4(g); return 0.f; }
        *(u32x2*)(GV + (size_t)row * 512 + (col - 1280)) = pack4(g);
        s1 = dot4(g, g);
        return (g[0] + g[1]) + (g[2] + g[3]);
    }
    __device__ __forceinline__ void rowstat(int row, int pn, int wc, float s0, float s1) const {
        if (pn >= 5) { float* p = LNP + (size_t)row * 16 + ((pn - 5) * 4 + wc) * 2; p[0] = s0; p[1] = s1; }
    }
};
struct QProj {
    static constexpr bool NEED_R = false, SWI = false, STAT = false;
    bf16_t* PP;
    __device__ __forceinline__ float quad(int row, int col, float r, f32x4 v, float& s1) const { s1 = 0.f; *(u32x2*)(PP + (size_t)row * DM + col) = pack4(v); return 0.f; }
};
struct QGate {
    static constexpr bool NEED_R = true, SWI = false, STAT = false;
    bf16_t* X; const bf16_t* XB; const bf16_t* PP;
    __device__ __forceinline__ float quad(int row, int col, float r, f32x4 v, float& s1) const {
        s1 = 0.f;
        const f32x4 pp = unpack4(*(const u32x2*)(PP + (size_t)row * DM + col));
        f32x4 x = unpack4(*(const u32x2*)(XB + (size_t)row * DM + col));
#pragma unroll
        for (int i = 0; i < 4; ++i) x[i] += sigmoid_(v[i] * r) * pp[i];
        *(u32x2*)(X + (size_t)row * DM + col) = pack4(x);
        return 0.f;
    }
};

template <class Q> struct EpiMain {
    static constexpr bool PERM = false, AFTER_DRAIN = false;
    Q q; const float* ss;
    __device__ __forceinline__ void operator()(const f32x4 (&acc)[2][2][4][2], const pg8::Unit& u, int wr, int wc, int fr, int fq) const {
        float rr[2][4];
        if constexpr (Q::NEED_R) {
            f32x4 p[2][4];
#pragma unroll
            for (int ai = 0; ai < 2; ++ai)
#pragma unroll
                for (int m = 0; m < 4; ++m) p[ai][m] = *(const f32x4*)(ss + (size_t)(u.pm * 256 + ai * 128 + wr * 64 + m * 16 + fr) * 16 + 4 * fq);
#pragma unroll
            for (int ai = 0; ai < 2; ++ai)
#pragma unroll
                for (int m = 0; m < 4; ++m) {
                    float s = (p[ai][m][0] + p[ai][m][1]) + (p[ai][m][2] + p[ai][m][3]); s += __shfl_xor(s, 16); s += __shfl_xor(s, 32);
                    rr[ai][m] = __builtin_amdgcn_rsqf(s * (1.0f / DM) + RMS_EPS);
                }
        }
#pragma unroll
        for (int ai = 0; ai < 2; ++ai) {
#pragma unroll
            for (int m = 0; m < 4; ++m) {
                const int row = u.pm * 256 + ai * 128 + wr * 64 + m * 16 + fr;
                float r = 1.f;
                if constexpr (Q::NEED_R) r = rr[ai][m];
                if constexpr (Q::SWI) {
#pragma unroll
                    for (int n = 0; n < 2; ++n) q.quad2(row, u.pn * 128 + wc * 32 + n * 16 + 4 * fq, r, acc[ai][0][m][n], acc[ai][1][m][n]);
                } else {
                    float s0 = 0.f, s1 = 0.f;
#pragma unroll
                    for (int bj = 0; bj < 2; ++bj)
#pragma unroll
                        for (int n = 0; n < 2; ++n) {
                            const int col = u.pn * 256 + bj * 128 + wc * 32 + n * 16 + 4 * fq;
                            float t1; s0 += q.quad(row, col, r, acc[ai][bj][m][n], t1); s1 += t1;
                        }
                    if constexpr (Q::STAT) {
                        s0 += __shfl_xor(s0, 16); s0 += __shfl_xor(s0, 32);
                        s1 += __shfl_xor(s1, 16); s1 += __shfl_xor(s1, 32);
                        if (fq == 0) q.rowstat(row, u.pn, wc, s0, s1);
                    }
                }
            }
            asm volatile("" ::: "memory");
        }
    }
};

struct UpperOrder {
    int nN, total, c, off, G2;
    __device__ void init(int M, int N, int G, int c_) { nN = N / 256; total = (M / 256) * nN; off = G / 2; G2 = G - off; c = c_; }
    __device__ bool next(int i, pg8::Unit& u) const { if (c < off) return false; const int L = i * G2 + (c - off); if (L >= total) return false; u.pm = L / nN; u.pn = L % nN; return true; }
    __device__ __forceinline__ void a_ready(const pg8::Unit&) const {}
    __device__ __forceinline__ void done(const pg8::Unit&) const {}
};

template <class Q>
__device__ __forceinline__ void skinny_gemm(LAS unsigned char* lds, const bf16_t* A, const bf16_t* Bt, int N, int K, const Q& q, int item0, int item_stride) {
    const int tid = threadIdx.x, wid = __builtin_amdgcn_readfirstlane(tid >> 6), lane = tid & 63, fr = lane & 15, fq = lane >> 4;
    LAS f32x4* red = (LAS f32x4*)lds;
    LAS float* redsq = (LAS float*)(lds + 65536);
    const int nitems = (N / 16) * 2, kw = K / 8, nsteps = kw / 32;
    for (int item = item0; item < nitems; item += item_stride) {
        const int nb = item >> 1, rh = item & 1;
        size_t brow0, brow1 = 0;
        if constexpr (Q::SWI) { const int hc = nb * 16 + fr; brow0 = (size_t)((hc >> 7) * 256 + (hc & 127)); brow1 = brow0 + 128; }
        else brow0 = (size_t)(nb * 16 + fr);
        f32x4 acc0[4], acc1[4]; float sq[4];
#pragma unroll
        for (int rt = 0; rt < 4; ++rt) { acc0[rt] = (f32x4){0.f, 0.f, 0.f, 0.f}; acc1[rt] = (f32x4){0.f, 0.f, 0.f, 0.f}; sq[rt] = 0.f; }
        const bf16_t* ap = A + (size_t)(rh * 64 + fr) * K + wid * kw + fq * 8;
        const bf16_t* bp0 = Bt + brow0 * K + wid * kw + fq * 8;
        const bf16_t* bp1 = Bt + brow1 * K + wid * kw + fq * 8;
        for (int s = 0; s < nsteps; ++s) {
            const bf16x8 b0 = *(const bf16x8*)(bp0 + s * 32);
            bf16x8 b1; if constexpr (Q::SWI) b1 = *(const bf16x8*)(bp1 + s * 32);
#pragma unroll
            for (int rt = 0; rt < 4; ++rt) {
                const bf16x8 a = *(const bf16x8*)(ap + (size_t)rt * 16 * K + s * 32);
                acc0[rt] = __builtin_amdgcn_mfma_f32_16x16x32_bf16(b0, a, acc0[rt], 0, 0, 0);
                if constexpr (Q::SWI) acc1[rt] = __builtin_amdgcn_mfma_f32_16x16x32_bf16(b1, a, acc1[rt], 0, 0, 0);
                if constexpr (Q::NEED_R) {
#pragma unroll
                    for (int e = 0; e < 8; ++e) { const float f = bf2f((unsigned short)a[e]); sq[rt] += f * f; }
                }
            }
        }
#pragma unroll
        for (int rt = 0; rt < 4; ++rt) {
            red[((wid * 2 + 0) * 4 + rt) * 64 + lane] = acc0[rt];
            if constexpr (Q::SWI) red[((wid * 2 + 1) * 4 + rt) * 64 + lane] = acc1[rt];
            if constexpr (Q::NEED_R) redsq[(wid * 4 + rt) * 64 + lane] = sq[rt];
        }
        __syncthreads();
        if (tid < 256) {
            const int rt = tid >> 6;
            f32x4 v0 = (f32x4){0.f, 0.f, 0.f, 0.f}, v1 = (f32x4){0.f, 0.f, 0.f, 0.f};
#pragma unroll
            for (int w = 0; w < 8; ++w) { v0 = v0 + red[((w * 2 + 0) * 4 + rt) * 64 + lane]; if constexpr (Q::SWI) v1 = v1 + red[((w * 2 + 1) * 4 + rt) * 64 + lane]; }
            float r = 1.f;
            if constexpr (Q::NEED_R) {
                float s = 0.f;
#pragma unroll
                for (int w = 0; w < 8; ++w)
#pragma unroll
                    for (int f = 0; f < 4; ++f) s += redsq[(w * 4 + rt) * 64 + f * 16 + fr];
                r = __builtin_amdgcn_rsqf(s * (1.0f / (float)K) + RMS_EPS);
            }
            const int row = MP + rh * 64 + rt * 16 + fr, col = nb * 16 + 4 * fq;
            if constexpr (Q::SWI) q.quad2(row, col, r, v0, v1); else { float t1; (void)q.quad(row, col, r, v0, t1); }
        }
        __syncthreads();
    }
}

__device__ __forceinline__ void p0_transpose_item(const float* W, int K, int N, const float* gk, bf16_t* WT, int mode, LAS float* scr, int item, int lane) {
    const int nblk = N / 32, kb = item / nblk, nb = item % nblk, k0 = 64 * kb, n0 = 32 * nb;
    float wv[32];
#pragma unroll
    for (int i = 0; i < 32; ++i) wv[i] = W[(size_t)(k0 + 2 * i + (lane >> 5)) * N + n0 + (lane & 31)];
    if (gk) {
#pragma unroll
        for (int i = 0; i < 32; ++i) wv[i] *= gk[k0 + 2 * i + (lane >> 5)];
    }
#pragma unroll
    for (int i = 0; i < 32; ++i) scr[(2 * i + (lane >> 5)) * 33 + (lane & 31)] = wv[i];
    asm volatile("s_waitcnt lgkmcnt(0)" ::: "memory");
    const int drow0 = mode == 0 ? n0 : ((n0 >> 7) * 256 + (n0 & 127) + (mode == 2 ? 128 : 0));
    const int c = lane & 7;
#pragma unroll
    for (int j = 0; j < 4; ++j) { const int n = (lane >> 3) + 8 * j; const LAS float* s = scr + (8 * c) * 33 + n;
        u32x4 o; o.x = pg8::cvt_pk_bf16(s[0 * 33], s[1 * 33]); o.y = pg8::cvt_pk_bf16(s[2 * 33], s[3 * 33]); o.z = pg8::cvt_pk_bf16(s[4 * 33], s[5 * 33]); o.w = pg8::cvt_pk_bf16(s[6 * 33], s[7 * 33]);
        *(u32x4*)(WT + (size_t)(drow0 + n) * K + k0 + 8 * c) = o; }
    asm volatile("s_waitcnt lgkmcnt(0)" ::: "memory");
}

struct Args { const float* in[28]; float* out; unsigned char* ws; int ph_lo, ph_hi; };

__device__ __forceinline__ void p0_prologue(const Args& a, LAS unsigned char* lds, int wid, int lane) {
    unsigned char* ws = a.ws;
    LAS float* scr = (LAS float*)(lds + wid * 16384);
    const int gw = blockIdx.x * 8 + wid, NGW = gridDim.x * 8;
    constexpr int I13 = (DM / 64) * (FF / 32), I2 = (FF / 64) * (DM / 32), IIN = (DM / 64) * (NIN / 32), ISQ = (DM / 64) * (DM / 32), IP = (PLE / 64) * (DM / 32);
    constexpr int NITEMS = 4 * I13 + 2 * I2 + IIN + 2 * ISQ + IP;
    for (int it = gw; it < NITEMS; it += NGW) {
        int r = it;
        if (r < I13) { p0_transpose_item(a.in[7], DM, FF, a.in[6], (bf16_t*)(ws + WS_W13A), 1, scr, r, lane); continue; } r -= I13;
        if (r < I13) { p0_transpose_item(a.in[8], DM, FF, a.in[6], (bf16_t*)(ws + WS_W13A), 2, scr, r, lane); continue; } r -= I13;
        if (r < I13) { p0_transpose_item(a.in[21], DM, FF, a.in[20], (bf16_t*)(ws + WS_W13B), 1, scr, r, lane); continue; } r -= I13;
        if (r < I13) { p0_transpose_item(a.in[22], DM, FF, a.in[20], (bf16_t*)(ws + WS_W13B), 2, scr, r, lane); continue; } r -= I13;
        if (r < I2) { p0_transpose_item(a.in[9], FF, DM, nullptr, (bf16_t*)(ws + WS_W2A), 0, scr, r, lane); continue; } r -= I2;
        if (r < I2) { p0_transpose_item(a.in[23], FF, DM, nullptr, (bf16_t*)(ws + WS_W2B), 0, scr, r, lane); continue; } r -= I2;
        if (r < IIN) { p0_transpose_item(a.in[11], DM, NIN, a.in[10], (bf16_t*)(ws + WS_WIN), 0, scr, r, lane); continue; } r -= IIN;
        if (r < ISQ) { p0_transpose_item(a.in[18], DM, DM, nullptr, (bf16_t*)(ws + WS_WOUT), 0, scr, r, lane); continue; } r -= ISQ;
        if (r < ISQ) { p0_transpose_item(a.in[25], DM, DM, a.in[24], (bf16_t*)(ws + WS_WG), 0, scr, r, lane); continue; } r -= ISQ;
        p0_transpose_item(a.in[26], PLE, DM, nullptr, (bf16_t*)(ws + WS_WP), 0, scr, r, lane);
    }
    bf16_t* XB = (bf16_t*)(ws + WS_XB); float* SS = (float*)(ws + WS_SS); bf16_t* PB = (bf16_t*)(ws + WS_PB);
    for (int m0 = gw; m0 < MT; m0 += 4 * NGW) {
        f32x4 v[4][4], pv[4];
#pragma unroll
        for (int q = 0; q < 4; ++q) {
            const int m = m0 + q * NGW;
            if (m < MT) {
                const float* xr = m < MP ? a.in[0] + (size_t)m * DM : a.in[1] + (size_t)(m - MP) * DM;
                const float* pr = m < MP ? a.in[4] + (size_t)m * PLE : a.in[5] + (size_t)(m - MP) * PLE;
#pragma unroll
                for (int j = 0; j < 4; ++j) v[q][j] = ((const f32x4*)xr)[lane + 64 * j];
                pv[q] = ((const f32x4*)pr)[lane];
            }
        }
#pragma unroll
        for (int q = 0; q < 4; ++q) {
            const int m = m0 + q * NGW;
            if (m < MT) {
#pragma unroll
                for (int j = 0; j < 4; ++j) {
                    ((u32x2*)(XB + (size_t)m * DM))[lane + 64 * j] = pack4(v[q][j]);
                    float s = dot4(v[q][j], v[q][j]);
                    s += __shfl_xor(s, 1); s += __shfl_xor(s, 2); s += __shfl_xor(s, 4); s += __shfl_xor(s, 8);
                    if ((lane & 15) == 0) SS[(size_t)m * 16 + 4 * j + (lane >> 4)] = s;
                }
                ((u32x2*)(PB + (size_t)m * PLE))[lane] = pack4(pv[q]);
            }
        }
    }
    {
        const int gt = blockIdx.x * 512 + threadIdx.x, NT = gridDim.x * 512;
        constexpr int NV = MS * 127 * 32;
        for (int i0 = gt; i0 < 2 * NV; i0 += 4 * NT) {
            f32x4 t[4]; float* dst[4];
#pragma unroll
            for (int q = 0; q < 4; ++q) {
                const int i = i0 + q * NT;
                if (i < 2 * NV) {
                    const int which = i >= NV, j = which ? i - NV : i;
                    const int b = j / (127 * 32), rem = j % (127 * 32), w = rem >> 5, c4 = rem & 31;
                    t[q] = *(const f32x4*)(a.in[2 + which] + ((size_t)(b * 128 + w + 1) * 128 + c4 * 4));
                    dst[q] = a.out + (which ? O_VWS : O_KWS) + ((size_t)(b * 128 + w) * 128 + c4 * 4);
                }
            }
#pragma unroll
            for (int q = 0; q < 4; ++q) if (i0 + q * NT < 2 * NV) *(f32x4*)dst[q] = t[q];
        }
    }
}

constexpr int KS_PITCH = 72, VT_PITCH = 264, VN_PITCH = 136;
__device__ __forceinline__ void attn_unit(LAS unsigned char* lds, int b, int h, int n, const bf16_t* Q, const bf16_t* Kb, const bf16_t* Vb, bf16_t* AB, const float* sinks) {
    const int tid = threadIdx.x, wid = __builtin_amdgcn_readfirstlane(tid >> 6), lane = tid & 63, fr = lane & 15, fq = lane >> 4;
    LAS bf16_t* Ks = (LAS bf16_t*)lds;
    LAS bf16_t* Vt = (LAS bf16_t*)(lds + 256 * KS_PITCH * 2);
    const bf16x8 zero8 = (bf16x8){0, 0, 0, 0, 0, 0, 0, 0};
    const int g = wid >> 1, ph = wid & 1, hq = h * 4 + g;
    bf16x8 qf[4][2];
#pragma unroll
    for (int mt = 0; mt < 4; ++mt)
#pragma unroll
        for (int kd = 0; kd < 2; ++kd) qf[mt][kd] = *(const bf16x8*)(Q + (size_t)(b * SEQ + n * 128 + ph * 64 + mt * 16 + fr) * 512 + hq * 64 + kd * 32 + fq * 8);
    const float sink = sinks[hq];
    {
        const int key = tid >> 1, half = tid & 1, kpos = (n - 1) * 128 + key;
        bf16x8 v[4];
#pragma unroll
        for (int j = 0; j < 4; ++j) v[j] = zero8;
        if (kpos >= 0) { const bf16x8* src = (const bf16x8*)(Kb + (size_t)(b * SEQ + kpos) * 128 + h * 64 + half * 32);
#pragma unroll
            for (int j = 0; j < 4; ++j) v[j] = src[j]; }
        bf16x8 v0[2], v1[2];
#pragma unroll
        for (int t2 = 0; t2 < 2; ++t2) {
            const int task = tid + 512 * t2, kp = task & 127, dc = task >> 7, c = 2 * kp, vpos = (n - 1) * 128 + c;
            v0[t2] = zero8; v1[t2] = zero8;
            if (vpos >= 0) { const bf16_t* src = Vb + (size_t)(b * SEQ + vpos) * 128 + h * 64 + dc * 8; v0[t2] = *(const bf16x8*)src; v1[t2] = *(const bf16x8*)(src + 128); }
        }
#pragma unroll
        for (int j = 0; j < 4; ++j) *(LAS bf16x8*)(Ks + key * KS_PITCH + half * 32 + j * 8) = v[j];
#pragma unroll
        for (int t2 = 0; t2 < 2; ++t2) {
            const int task = tid + 512 * t2, kp = task & 127, dc = task >> 7, c = 2 * kp;
#pragma unroll
            for (int e = 0; e < 8; ++e) *(LAS unsigned*)(Vt + (dc * 8 + e) * VT_PITCH + c) = (unsigned)(unsigned short)v0[t2][e] | ((unsigned)(unsigned short)v1[t2][e] << 16);
        }
    }
    __syncthreads();
#pragma unroll
    for (int mt = 0; mt < 4; ++mt) {
        const int p0 = ph * 64 + mt * 16, p = p0 + fr, kt0 = p0 >> 5;
        const size_t qrow = (size_t)(b * SEQ + n * 128 + p);
        const int dd = (mt & 1) * 16;
        f32x4 s[5][2];
#pragma unroll
        for (int j = 0; j < 5; ++j)
#pragma unroll
            for (int hh = 0; hh < 2; ++hh) {
                const int off = 16 * (2 * j + hh) - dd;
                f32x4 acc = (f32x4){0.f, 0.f, 0.f, 0.f};
                if (off >= 0 && off <= 128) {
                    const int c0 = 32 * (kt0 + j) + 16 * hh;
#pragma unroll
                    for (int kd = 0; kd < 2; ++kd) { const bf16x8 kf = *(const LAS bf16x8*)(Ks + (c0 + fr) * KS_PITCH + kd * 32 + fq * 8); acc = __builtin_amdgcn_mfma_f32_16x16x32_bf16(kf, qf[mt][kd], acc, 0, 0, 0); }
                    if (off == 0) {
#pragma unroll
                        for (int i = 0; i < 4; ++i) acc[i] = (4 * fq + i >= fr) ? acc[i] : -INFINITY;
                    } else if (off == 128) {
#pragma unroll
                        for (int i = 0; i < 4; ++i) acc[i] = (4 * fq + i <= fr) ? acc[i] : -INFINITY;
                    }
                } else acc = (f32x4){-INFINITY, -INFINITY, -INFINITY, -INFINITY};
                s[j][hh] = acc;
            }
        if (n == 0) {
#pragma unroll
            for (int j = 0; j < 5; ++j)
#pragma unroll
                for (int hh = 0; hh < 2; ++hh)
#pragma unroll
                    for (int i = 0; i < 4; ++i) { const int c = 32 * (kt0 + j) + 16 * hh + 4 * fq + i; s[j][hh][i] = (c >= 128) ? s[j][hh][i] : -INFINITY; }
        }
        float mx = -INFINITY;
#pragma unroll
        for (int j = 0; j < 5; ++j)
#pragma unroll
            for (int hh = 0; hh < 2; ++hh) {
                const int off = 16 * (2 * j + hh) - dd;
                if (off >= 0 && off <= 128) mx = fmaxf(mx, fmaxf(fmaxf(s[j][hh][0], s[j][hh][1]), fmaxf(s[j][hh][2], s[j][hh][3])));
            }
        mx = fmaxf(mx, __shfl_xor(mx, 16)); mx = fmaxf(mx, __shfl_xor(mx, 32)); mx = fmaxf(mx, sink);
        const float mxl = mx * 1.44269504089f;
        float sum = 0.f;
#pragma unroll
        for (int j = 0; j < 5; ++j)
#pragma unroll
            for (int hh = 0; hh < 2; ++hh) {
                const int off = 16 * (2 * j + hh) - dd;
                if (off >= 0 && off <= 128) {
#pragma unroll
                    for (int i = 0; i < 4; ++i) { const float e = __builtin_amdgcn_exp2f(s[j][hh][i] * 1.44269504089f - mxl); s[j][hh][i] = e; sum += e; }
                } else s[j][hh] = (f32x4){0.f, 0.f, 0.f, 0.f};
            }
        sum += __shfl_xor(sum, 16); sum += __shfl_xor(sum, 32); sum += fast_exp(sink - mx);
        const float inv = 1.0f / sum;
        f32x4 o[4];
#pragma unroll
        for (int dt = 0; dt < 4; ++dt) o[dt] = (f32x4){0.f, 0.f, 0.f, 0.f};
#pragma unroll
        for (int j = 0; j < 5; ++j) {
            const u32x2 plo = pack4(s[j][0]), phi = pack4(s[j][1]);
            const u32x4 pw = (u32x4){plo.x, plo.y, phi.x, phi.y};
            const bf16x8 pf = __builtin_bit_cast(bf16x8, pw);
#pragma unroll
            for (int dt = 0; dt < 4; ++dt) {
                const LAS bf16_t* vp = Vt + (16 * dt + fr) * VT_PITCH + 32 * (kt0 + j) + 4 * fq;
                const u32x2 lo = *(const LAS u32x2*)vp, hi = *(const LAS u32x2*)(vp + 16);
                const u32x4 vw = (u32x4){lo.x, lo.y, hi.x, hi.y};
                o[dt] = __builtin_amdgcn_mfma_f32_16x16x32_bf16(__builtin_bit_cast(bf16x8, vw), pf, o[dt], 0, 0, 0);
            }
        }
#pragma unroll
        for (int dt = 0; dt < 4; ++dt) *(u32x2*)(AB + qrow * DM + hq * 64 + 16 * dt + 4 * fq) = pack4(o[dt] * inv);
    }
    __syncthreads();
}

__device__ __forceinline__ void gmlp_unit(LAS unsigned char* lds, int b, int n, int g, const bf16_t* GU, const bf16_t* GV, const float* LNP, bf16_t* AB,
                                          const float* ln_g, const float* ln_b, const float* w_s, const float* b_s, float* out) {
    const int tid = threadIdx.x, wid = __builtin_amdgcn_readfirstlane(tid >> 6), lane = tid & 63, fr = lane & 15, fq = lane >> 4;
    LAS bf16_t* vnT = (LAS bf16_t*)lds;
    const size_t row0 = (size_t)(b * SEQ + n * 128);
    const int t = 16 * wid + fr, nks = (wid >> 1) + 1;
    const size_t row = row0 + t;
    bf16x8 wf[4];
#pragma unroll
    for (int ks = 0; ks < 4; ++ks) {
        wf[ks] = (bf16x8){0, 0, 0, 0, 0, 0, 0, 0};
        if (ks < nks) {
            const int s0 = 32 * ks + 8 * fq;
            const float* wp = w_s + ((size_t)(g * 128 + t) * 128 + s0);
            const f32x4 w0 = *(const f32x4*)wp, w1 = *(const f32x4*)(wp + 4);
            float wv[8] = {w0[0], w0[1], w0[2], w0[3], w1[0], w1[1], w1[2], w1[3]};
#pragma unroll
            for (int e = 0; e < 8; ++e) wv[e] = (s0 + e <= t) ? wv[e] : 0.f;
            const u32x4 ww = (u32x4){pg8::cvt_pk_bf16(wv[0], wv[1]), pg8::cvt_pk_bf16(wv[2], wv[3]), pg8::cvt_pk_bf16(wv[4], wv[5]), pg8::cvt_pk_bf16(wv[6], wv[7])};
            wf[ks] = __builtin_bit_cast(bf16x8, ww);
        }
    }
    u32x2 guw[8];
#pragma unroll
    for (int ct = 0; ct < 8; ++ct) guw[ct] = *(const u32x2*)(GU + row * 512 + g * 128 + 16 * ct + 4 * fq);
    const float bias = b_s[g * 128 + t];
#pragma unroll
    for (int t2 = 0; t2 < 2; ++t2) {
        const int task = tid + 512 * t2, sp = task & 63, cc = task >> 6, s = 2 * sp;
        float mean[2], rstd[2]; f32x4 x[2][2];
#pragma unroll
        for (int rr = 0; rr < 2; ++rr) {
            const f32x4* lp = (const f32x4*)(LNP + (row0 + s + rr) * 16);
            float su = 0.f, sq = 0.f;
#pragma unroll
            for (int k = 0; k < 4; ++k) { const f32x4 tt = lp[k]; su += tt[0] + tt[2]; sq += tt[1] + tt[3]; }
            mean[rr] = su * (1.0f / 512.0f);
            const float var = fmaxf(sq * (1.0f / 512.0f) - mean[rr] * mean[rr], 0.f);
            rstd[rr] = __builtin_amdgcn_rsqf(var + LN_EPS);
            const u32x4 w = *(const u32x4*)(GV + (row0 + s + rr) * 512 + g * 128 + cc * 8);
            x[rr][0] = unpack4((u32x2){w.x, w.y}); x[rr][1] = unpack4((u32x2){w.z, w.w});
        }
        const f32x4 g0 = *(const f32x4*)(ln_g + g * 128 + cc * 8), g1 = *(const f32x4*)(ln_g + g * 128 + cc * 8 + 4);
        const f32x4 b0 = *(const f32x4*)(ln_b + g * 128 + cc * 8), b1 = *(const f32x4*)(ln_b + g * 128 + cc * 8 + 4);
#pragma unroll
        for (int rr = 0; rr < 2; ++rr) { x[rr][0] = (x[rr][0] - mean[rr]) * rstd[rr] * g0 + b0; x[rr][1] = (x[rr][1] - mean[rr]) * rstd[rr] * g1 + b1; }
        if (n == SEQ / 128 - 1) {
#pragma unroll
            for (int rr = 0; rr < 2; ++rr) { float* o = out + O_GVP + ((size_t)(b * 128 + s + rr) * 512 + g * 128 + cc * 8); *(f32x4*)o = x[rr][0]; *(f32x4*)(o + 4) = x[rr][1]; }
        }
#pragma unroll
        for (int e = 0; e < 8; ++e) *(LAS unsigned*)(vnT + (cc * 8 + e) * VN_PITCH + s) = pg8::cvt_pk_bf16(x[0][e >> 2][e & 3], x[1][e >> 2][e & 3]);
    }
    __syncthreads();
    f32x4 acc[8];
#pragma unroll
    for (int ct = 0; ct < 8; ++ct) acc[ct] = (f32x4){0.f, 0.f, 0.f, 0.f};
#pragma unroll
    for (int ks = 0; ks < 4; ++ks) {
        if (ks < nks) {
#pragma unroll
            for (int ct = 0; ct < 8; ++ct) {
                const bf16x8 vf = *(const LAS bf16x8*)(vnT + (16 * ct + fr) * VN_PITCH + 32 * ks + 8 * fq);
                acc[ct] = __builtin_amdgcn_mfma_f32_16x16x32_bf16(vf, wf[ks], acc[ct], 0, 0, 0);
            }
        }
    }
#pragma unroll
    for (int ct = 0; ct < 8; ++ct) *(u32x2*)(AB + row * DM + 512 + g * 128 + 16 * ct + 4 * fq) = pack4(unpack4(guw[ct]) * (acc[ct] + bias));
    __syncthreads();
}

__device__ __forceinline__ void sample_mixer(LAS unsigned char* lds, int b, const Args& a, const bf16_t* Q, const bf16_t* GU, const bf16_t* GV, bf16_t* AB) {
    const int tid = threadIdx.x, wid = __builtin_amdgcn_readfirstlane(tid >> 6), lane = tid & 63;
    LAS float* qs = (LAS float*)lds;
    LAS float* pw = (LAS float*)(lds + 2048) + wid * 136;
    LAS float* rs = (LAS float*)(lds + 2048 + 8 * 136 * 4);
    const size_t row = (size_t)MP + b;
    qs[tid] = bf2f(Q[row * 512 + tid]);
    const float gv = bf2f(GV[row * 512 + tid]);
    const float guv = bf2f(GU[row * 512 + tid]);
    {
        float su = gv, sq = gv * gv;
#pragma unroll
        for (int o = 1; o < 64; o <<= 1) { su += __shfl_xor(su, o); sq += __shfl_xor(sq, o); }
        if (lane == 0) { rs[wid] = su; rs[8 + wid] = sq; }
    }
    __syncthreads();
    {
        float su = 0.f, sq = 0.f;
#pragma unroll
        for (int w = 0; w < 8; ++w) { su += rs[w]; sq += rs[8 + w]; }
        const float mean = su * (1.0f / 512.0f), var = fmaxf(sq * (1.0f / 512.0f) - mean * mean, 0.f), rstd = __builtin_amdgcn_rsqf(var + LN_EPS);
        const float vn = (gv - mean) * rstd * a.in[14][tid] + a.in[15][tid];
        a.out[O_GVS + (size_t)b * 512 + tid] = vn;
        const int g = tid >> 7;
        const float mix = a.in[16][(size_t)g * 128 * 128] * vn + a.in[17][g * 128];
        AB[row * DM + 512 + tid] = (bf16_t)(pg8::cvt_pk_bf16(guv * mix, 0.f) & 0xffffu);
    }
    {
        const int hq = wid, kvh = hq >> 2;
        const f32x4* k0 = (const f32x4*)(a.in[2] + ((size_t)(b * 128 + lane) * 2 + kvh) * 64);
        const f32x4* k1 = (const f32x4*)(a.in[2] + ((size_t)(b * 128 + lane + 64) * 2 + kvh) * 64);
        const f32x4* kn = (const f32x4*)(a.out + O_KWS + ((size_t)(b * 128 + 127) * 2 + kvh) * 64);
        const LAS f32x4* q4 = (const LAS f32x4*)(qs + hq * 64);
        float s0 = 0.f, s1 = 0.f, s2 = 0.f;
#pragma unroll 8
        for (int d = 0; d < 16; ++d) { const f32x4 qv = q4[d]; s0 += dot4(qv, k0[d]); s1 += dot4(qv, k1[d]); s2 += dot4(qv, kn[d]); }
        const float sink = a.in[13][hq];
        float mx = fmaxf(fmaxf(s0, s1), s2);
#pragma unroll
        for (int o = 1; o < 64; o <<= 1) mx = fmaxf(mx, __shfl_xor(mx, o));
        mx = fmaxf(mx, sink);
        const float e0 = fast_exp(s0 - mx), e1 = fast_exp(s1 - mx), e2 = fast_exp(s2 - mx);
        float sum = e0 + e1;
#pragma unroll
        for (int o = 1; o < 64; o <<= 1) sum += __shfl_xor(sum, o);
        sum += e2 + fast_exp(sink - mx);
        pw[lane] = e0; pw[64 + lane] = e1;
        asm volatile("s_waitcnt lgkmcnt(0)" ::: "memory");
        const int cpart = lane >> 4, dch = lane & 15;
        const float* vb = a.in[3] + ((size_t)(b * 128 + cpart * 32) * 2 + kvh) * 64 + dch * 4;
        f32x4 o = (f32x4){0.f, 0.f, 0.f, 0.f};
#pragma unroll
        for (int hb = 0; hb < 2; ++hb) {
            f32x4 vv[16];
#pragma unroll
            for (int c = 0; c < 16; ++c) vv[c] = *(const f32x4*)(vb + (size_t)(hb * 16 + c) * 128);
#pragma unroll
            for (int c = 0; c < 16; ++c) o = o + vv[c] * pw[cpart * 32 + hb * 16 + c];
        }
#pragma unroll
        for (int i = 0; i < 4; ++i) { o[i] += __shfl_xor(o[i], 16); o[i] += __shfl_xor(o[i], 32); }
        if (cpart == 0) {
            const f32x4 vn4 = *(const f32x4*)(a.out + O_VWS + ((size_t)(b * 128 + 127) * 2 + kvh) * 64 + dch * 4);
            o = (o + vn4 * e2) * (1.0f / sum);
            *(u32x2*)(AB + row * DM + hq * 64 + dch * 4) = pack4(o);
        }
    }
    __syncthreads();
}

#define XB_TMO      128
#define XB_XCNT(j)  (256  + 64 * (j))
#define XB_XSUB(j)  (1280 + 64 * (j))
#define XB_XGEN(j)  (2304 + 64 * (j))
#define XB_TOP      3328
#define XB_TOPGEN   3392
#define XCD_BAR_WORDS 3456
#define XB_SPIN_CAP (1u << 18)

__device__ __forceinline__ unsigned xb_ld(unsigned* p)              { return __hip_atomic_load(p, __ATOMIC_RELAXED, __HIP_MEMORY_SCOPE_AGENT); }
__device__ __forceinline__ unsigned xb_add(unsigned* p, unsigned v) { return __hip_atomic_fetch_add(p, v, __ATOMIC_RELAXED, __HIP_MEMORY_SCOPE_AGENT); }
__device__ __forceinline__ unsigned xb_xcc_id() { return (unsigned)__builtin_amdgcn_s_getreg((3 << 11) | 20) & 0xFu; }
#define XB_SPIN(cond, bar) do { unsigned _sp = 0; while (cond) { __builtin_amdgcn_s_sleep(1); \
    if ((++_sp & 255u) == 0u) { if (xb_ld(&(bar)[XB_TMO])) break; if (_sp > XB_SPIN_CAP) { atomicAdd(&(bar)[XB_TMO], 1u); break; } } } } while (0)

struct XcdBarrier {
    unsigned* bar; unsigned x;
    volatile LAS unsigned* st;
};

__device__ __forceinline__ XcdBarrier xcd_barrier_post(unsigned* bar, volatile LAS unsigned* st) {
    XcdBarrier b; b.bar = bar; b.x = xb_xcc_id(); b.st = st;
    if (threadIdx.x == 0) (void)xb_add(&bar[XB_XCNT(b.x)], 1u);
    return b;
}
__device__ __forceinline__ void xcd_barrier_complete(unsigned* bar, unsigned x, unsigned& nloc, unsigned& nx) {
    const unsigned G = gridDim.x * gridDim.y * gridDim.z;
    unsigned sum, cnt, mine, sp = 0u;
    for (;;) {
        sum = 0u; cnt = 0u; mine = 0u;
#pragma unroll
        for (unsigned j = 0; j < 16; ++j) { const unsigned c = xb_ld(&bar[XB_XCNT(j)]); sum += c; cnt += (c > 0u) ? 1u : 0u; mine = (j == x) ? c : mine; }
        if (sum == G) break;
        __builtin_amdgcn_s_sleep(1);
        if ((++sp & 255u) == 0u) { if (xb_ld(&bar[XB_TMO])) break; if (sp > XB_SPIN_CAP) { atomicAdd(&bar[XB_TMO], 1u); break; } }
    }
    nloc = mine > 0u ? mine : 1u; nx = cnt > 0u ? cnt : 1u;
}

__device__ __forceinline__ void xcd_barrier(const XcdBarrier& b) {
    asm volatile("s_waitcnt vmcnt(0)" ::: "memory");
    __syncthreads();
    if (threadIdx.x == 0) {
        unsigned* bar = b.bar;
        __builtin_amdgcn_s_waitcnt(0);
        unsigned nloc = b.st[0], nx = b.st[1];
        if (nloc == 0u) { xcd_barrier_complete(bar, b.x, nloc, nx); b.st[0] = nloc; b.st[1] = nx; }
        const unsigned old = xb_add(&bar[XB_XSUB(b.x)], 1u);
        const unsigned gen = old / nloc;
        if (old + 1u == (gen + 1u) * nloc) {
            __builtin_amdgcn_fence(__ATOMIC_RELEASE, "agent");
            asm volatile("s_waitcnt vmcnt(0)" ::: "memory");
            const unsigned og = xb_add(&bar[XB_TOP], 1u);
            const unsigned tg = og / nx;
            if (og + 1u == (tg + 1u) * nx) xb_add(&bar[XB_TOPGEN], 1u);
            else XB_SPIN(xb_ld(&bar[XB_TOPGEN]) == tg, bar);
            __builtin_amdgcn_fence(__ATOMIC_ACQUIRE, "agent");
            xb_add(&bar[XB_XGEN(b.x)], 1u);
            asm volatile("s_waitcnt vmcnt(0)" ::: "memory");
        } else {
            XB_SPIN(xb_ld(&bar[XB_XGEN(b.x)]) == gen, bar);
            __builtin_amdgcn_fence(__ATOMIC_ACQUIRE, "agent");
            asm volatile("s_waitcnt vmcnt(0)" ::: "memory");
        }
    }
    __syncthreads();
}

template <bool COOP>
__global__ void __launch_bounds__(512, 2) mk_fwd(Args a) {
    extern __shared__ __attribute__((aligned(16))) unsigned char lds_raw[];
    LAS unsigned char* lds = (LAS unsigned char*)lds_raw;
    const int tid = threadIdx.x, wid = __builtin_amdgcn_readfirstlane(tid >> 6), lane = tid & 63;
    const int G = gridDim.x, bx = blockIdx.x;
    unsigned char* ws = a.ws;
    bf16_t* W13A = (bf16_t*)(ws + WS_W13A); bf16_t* W2A = (bf16_t*)(ws + WS_W2A); bf16_t* W13B = (bf16_t*)(ws + WS_W13B); bf16_t* W2B = (bf16_t*)(ws + WS_W2B);
    bf16_t* WIN = (bf16_t*)(ws + WS_WIN); bf16_t* WOUT = (bf16_t*)(ws + WS_WOUT); bf16_t* WG = (bf16_t*)(ws + WS_WG); bf16_t* WP = (bf16_t*)(ws + WS_WP);
    bf16_t* XB = (bf16_t*)(ws + WS_XB); bf16_t* PB = (bf16_t*)(ws + WS_PB); bf16_t* PP = (bf16_t*)(ws + WS_PP);
    float* SS = (float*)(ws + WS_SS); float* LNP = (float*)(ws + WS_LNP);
    bf16_t* H = (bf16_t*)(ws + WS_H); bf16_t* Qb = (bf16_t*)(ws + WS_Q); bf16_t* Kb = (bf16_t*)(ws + WS_K); bf16_t* Vb = (bf16_t*)(ws + WS_V);
    bf16_t* GU = (bf16_t*)(ws + WS_GU); bf16_t* GV = (bf16_t*)(ws + WS_GV); bf16_t* AB = (bf16_t*)(ws + WS_AB);
    float* X = a.out;
    const int lo = a.ph_lo, hi = a.ph_hi;
    XcdBarrier bar; bar.bar = (unsigned*)(ws + WS_CTL); bar.x = 0; bar.st = (volatile LAS unsigned*)(lds + LDS_ST_OFF);
    if constexpr (COOP) {
        if (tid < 2) bar.st[tid] = 0u;
        __syncthreads();
        bar = xcd_barrier_post((unsigned*)(ws + WS_CTL), (volatile LAS unsigned*)(lds + LDS_ST_OFF));
        if (hi > 1000) cg::this_grid().sync();
    }
#define IN(k) (lo <= (k) && (k) < hi)
#define SEAM(k) do { if constexpr (COOP) { if (IN(k) && IN((k) + 1)) xcd_barrier(bar); } } while (0)

    if (IN(0)) p0_prologue(a, lds, wid, lane);
    SEAM(0);
    if (IN(1)) {
        pg8::Gemm g{XB, W13A, MP, 2 * FF, DM}; pg8::StaticOrder S; S.init(MP, 2 * FF, G, bx);
        EpiMain<QSwiglu> E{QSwiglu{H}, SS};
        pg8::gemm_phase<EpiMain<QSwiglu>, pg8::StaticOrder, true, true>(lds, g, S, E);
        skinny_gemm<QSwiglu>(lds, XB + (size_t)MP * DM, W13A, FF, DM, E.q, bx, G);
    }
    SEAM(1);
    if (IN(2)) {
        pg8::Gemm g{H, W2A, MP, DM, FF}; pg8::StaticOrder S; S.init(MP, DM, G, bx);
        EpiMain<QResid> E{QResid{XB, nullptr, SS, 0.5f}, nullptr};
        pg8::gemm_phase<EpiMain<QResid>, pg8::StaticOrder, true, true>(lds, g, S, E);
        skinny_gemm<QResid>(lds, H + (size_t)MP * FF, W2A, DM, FF, E.q, bx, G);
    }
    SEAM(2);
    if (IN(3)) {
        {
            pg8::Gemm g{XB, WIN, MP, NIN, DM}; pg8::StaticOrder S; S.init(MP, NIN, G, bx);
            EpiMain<QWin> E{QWin{a.in[12], Qb, Kb, Vb, GU, GV, LNP, a.out}, SS};
            pg8::gemm_phase<EpiMain<QWin>, pg8::StaticOrder, true, true>(lds, g, S, E);
            skinny_gemm<QWin>(lds, XB + (size_t)MP * DM, WIN, NIN, DM, E.q, bx, G);
        }
        {
            int kp = PLE; asm volatile("" : "+s"(kp));
            pg8::Gemm g{PB, WP, MP, DM, kp}; UpperOrder S; S.init(MP, DM, G, bx);
            EpiMain<QProj> E{QProj{PP}, nullptr};
            pg8::gemm_phase<EpiMain<QProj>, UpperOrder, true, true>(lds, g, S, E);
            skinny_gemm<QProj>(lds, PB + (size_t)MP * PLE, WP, DM, PLE, E.q, bx, G);
        }
    }
    SEAM(3);
    if (IN(4)) {
        for (int u = bx; u < NBATCH * 2 * 32; u += G) { const int n = u & 31, h = (u >> 5) & 1, b = u >> 6; attn_unit(lds, b, h, n, Qb, Kb, Vb, AB, a.in[13]); }
        for (int u = bx; u < NBATCH * 32 * 4; u += G) { const int g = u & 3, n = (u >> 2) & 31, b = u >> 7; gmlp_unit(lds, b, n, g, GU, GV, LNP, AB, a.in[14], a.in[15], a.in[16], a.in[17], a.out); }
        for (int u = bx; u < MS; u += G) sample_mixer(lds, u, a, Qb, GU, GV, AB);
    }
    SEAM(4);
    if (IN(5)) {
        pg8::Gemm g{AB, WOUT, MP, DM, DM}; pg8::StaticOrder S; S.init(MP, DM, G, bx);
        EpiMain<QResid> E{QResid{XB, a.in[19], SS, 1.0f}, nullptr};
        pg8::gemm_phase<EpiMain<QResid>, pg8::StaticOrder, true, true>(lds, g, S, E);
        skinny_gemm<QResid>(lds, AB + (size_t)MP * DM, WOUT, DM, DM, E.q, bx, G);
    }
    SEAM(5);
    if (IN(6)) {
        pg8::Gemm g{XB, W13B, MP, 2 * FF, DM}; pg8::StaticOrder S; S.init(MP, 2 * FF, G, bx);
        EpiMain<QSwiglu> E{QSwiglu{H}, SS};
        pg8::gemm_phase<EpiMain<QSwiglu>, pg8::StaticOrder, true, true>(lds, g, S, E);
        skinny_gemm<QSwiglu>(lds, XB + (size_t)MP * DM, W13B, FF, DM, E.q, bx, G);
    }
    SEAM(6);
    if (IN(7)) {
        pg8::Gemm g{H, W2B, MP, DM, FF}; pg8::StaticOrder S; S.init(MP, DM, G, bx);
        EpiMain<QResid> E{QResid{XB, nullptr, SS, 0.5f}, nullptr};
        pg8::gemm_phase<EpiMain<QResid>, pg8::StaticOrder, true, true>(lds, g, S, E);
        skinny_gemm<QResid>(lds, H + (size_t)MP * FF, W2B, DM, FF, E.q, bx, G);
    }
    SEAM(7);
    if (IN(8)) {
        pg8::Gemm g{XB, WG, MP, DM, DM}; pg8::StaticOrder S; S.init(MP, DM, G, bx);
        EpiMain<QGate> E{QGate{H, XB, PP}, SS};
        pg8::gemm_phase<EpiMain<QGate>, pg8::StaticOrder, true, true>(lds, g, S, E);
        skinny_gemm<QGate>(lds, XB + (size_t)MP * DM, WG, DM, DM, E.q, bx, G);
    }
    SEAM(8);
    if (IN(9)) {
        const int gw = bx * 8 + wid, NGW = G * 8;
        const float* gf = a.in[27];
        f32x4 gg[4];
#pragma unroll
        for (int j = 0; j < 4; ++j) gg[j] = ((const f32x4*)gf)[lane + 64 * j];
        for (int m0 = gw; m0 < MT; m0 += 4 * NGW) {
            u32x2 w[4][4];
#pragma unroll
            for (int q = 0; q < 4; ++q) { const int m = m0 + q * NGW; if (m < MT) {
#pragma unroll
                for (int j = 0; j < 4; ++j) w[q][j] = ((const u32x2*)(H + (size_t)m * DM))[lane + 64 * j]; } }
#pragma unroll
            for (int q = 0; q < 4; ++q) { const int m = m0 + q * NGW; if (m < MT) {
                f32x4* yr = (f32x4*)(X + (size_t)m * DM);
                f32x4 v[4]; float s = 0.f;
#pragma unroll
                for (int j = 0; j < 4; ++j) { v[j] = unpack4(w[q][j]); s += dot4(v[j], v[j]); }
#pragma unroll
                for (int o = 1; o < 64; o <<= 1) s += __shfl_xor(s, o);
                const float r = __builtin_amdgcn_rsqf(s * (1.0f / DM) + RMS_EPS);
#pragma unroll
                for (int j = 0; j < 4; ++j) yr[lane + 64 * j] = v[j] * r * gg[j]; } }
        }
    }
#undef IN
#undef SEAM
}

extern "C" void kernel_launch(void* const* d_in, const int* in_sizes, int n_in, void* d_out, int out_size, void* d_ws, size_t ws_size, hipStream_t stream) {
    static int grid = 0;
    constexpr bool COOP = (MK_COOP != 0);
    const void* fn = (const void*)mk_fwd<COOP>;
    if (grid == 0) {
        if (n_in != 28 || (size_t)out_size != O_END || ws_size < WS_TOTAL) { fprintf(stderr, "kernel_launch: unexpected shapes (n_in %d out %d ws %zu, need %zu)\n", n_in, out_size, ws_size, (size_t)WS_TOTAL); grid = -1; return; }
        int dev = 0, cus = 0, per_cu = 0;
        (void)hipGetDevice(&dev);
        (void)hipDeviceGetAttribute(&cus, hipDeviceAttributeMultiprocessorCount, dev);
        if (hipFuncSetAttribute(fn, hipFuncAttributeMaxDynamicSharedMemorySize, LDS_BYTES) != hipSuccess) { fprintf(stderr, "kernel_launch: hipFuncSetAttribute failed\n"); grid = -1; return; }
        if (hipOccupancyMaxActiveBlocksPerMultiprocessor(&per_cu, fn, 512, LDS_BYTES) != hipSuccess || per_cu < 1) { fprintf(stderr, "kernel_launch: occupancy query says %d\n", per_cu); per_cu = 1; }
        (void)hipGetLastError();
        grid = cus;
    }
    if (grid < 0) return;
    Args a{};
    for (int i = 0; i < 28; ++i) a.in[i] = (const float*)d_in[i];
    a.out = (float*)d_out; a.ws = (unsigned char*)d_ws;
    if (COOP) {
        if (hipMemsetAsync((char*)d_ws + WS_CTL, 0, CTL_BYTES, stream) != hipSuccess) { fprintf(stderr, "kernel_launch: memset of the barrier words failed\n"); return; }
        a.ph_lo = 0; a.ph_hi = NPHASE;
        void* args[] = {&a};
        hipError_t e = hipLaunchCooperativeKernel(fn, dim3(grid), dim3(512), args, LDS_BYTES, stream);
        if (e != hipSuccess) fprintf(stderr, "cooperative launch failed: %s (grid %d)\n", hipGetErrorString(e), grid);
    } else {
        for (int p = 0; p < NPHASE; ++p) { a.ph_lo = p; a.ph_hi = p + 1; hipLaunchKernelGGL(mk_fwd<COOP>, dim3(grid), dim3(512), LDS_BYTES, stream, a); }
    }
}
```
